# Optimizing an MI355X kernel written in HIP

```python
import math
import jax, jax.numpy as jnp
from jax import lax
import numpy as np

D_MODEL = 1024
BATCH = 4
SEQ = 8192
DEPTH = 4

GRID_W = 64
CTX_LEN = 256
N_MIXERS = 3
D_FF = 2816
N_MOD = 9
EPS = 1e-6

SSD_D_INNER = 2 * D_MODEL
SSD_HEAD_DIM = 64
SSD_N_HEADS = SSD_D_INNER // SSD_HEAD_DIM
SSD_N_GROUPS = 4
SSD_D_STATE = 128
SSD_CONV_W = 5
SSD_CHUNK = 128
SSD_GN = SSD_N_GROUPS * SSD_D_STATE
SSD_CONV_DIM = SSD_D_INNER + 2 * SSD_GN
SSD_IN_DIM = SSD_D_INNER + SSD_CONV_DIM + 2 * SSD_N_HEADS

POOL_WINDOWS = (2, 4, 8, 16)
POOL_GROUPS = 4
POOL_GROUP_DIM = D_MODEL // POOL_GROUPS

HY_ORDER = 2
HY_SHORT_W = 3
HY_EMB_DIM = 33
HY_BANDS = (HY_EMB_DIM - 1) // 2
HY_FILTER_HIDDEN = 64
HY_MAX_DECAY = math.log(1e-2) / 0.3
HY_MIN_DECAY = math.log(1e-2) / 1.5

kernel_name = "hybrid_ssd_pool_hyena_prefix_dit"


def rmsnorm(x, g):
    xf = x.astype(jnp.float32)
    y = xf * lax.rsqrt(jnp.mean(xf * xf, axis=-1, keepdims=True) + EPS)
    return (y * g.astype(jnp.float32)).astype(x.dtype)


def modulate(x, g, shift, scale):
    return rmsnorm(x, g) * (1 + scale) + shift


def swiglu(u, wg, wu, wd):
    return (jax.nn.silu(u @ wg) * (u @ wu)) @ wd


def dwconv_centred(u, w, b):
    K = w.shape[0]
    P = K // 2
    L = u.shape[1]
    up = jnp.pad(u, ((0, 0), (P, P), (0, 0)))
    out = b
    for k in range(K):
        out = out + w[k] * up[:, k:k + L]
    return out


def ssd_scan(x, dt, A, B, C, h0, with_output):
    b, l, H, P = x.shape
    G, N = B.shape[2], B.shape[3]
    E = H // G
    Q = SSD_CHUNK
    nc = l // Q
    xdt = (x.astype(jnp.float32) * dt[..., None]).reshape(b, nc, Q, G, E, P)
    Bc = B.astype(jnp.float32).reshape(b, nc, Q, G, N)
    Cc = C.astype(jnp.float32).reshape(b, nc, Q, G, N)
    a_cum = jnp.cumsum((dt * A).reshape(b, nc, Q, G, E), axis=2)
    a_last = a_cum[:, :, -1]
    decay_to_end = jnp.exp(a_last[:, :, None] - a_cum)
    states = jnp.einsum('bcsgn,bcsge,bcsgep->bcgepn', Bc, decay_to_end, xdt)

    def step(h, inp):
        st, al = inp
        return h * jnp.exp(al)[..., None, None] + st, h

    h_final, h_in = lax.scan(step, h0, (jnp.moveaxis(states, 1, 0), jnp.moveaxis(a_last, 1, 0)))
    if not with_output:
        return None, h_final
    h_in = jnp.moveaxis(h_in, 0, 1)
    seg = a_cum[:, :, :, None] - a_cum[:, :, None, :]
    mask = jnp.tril(jnp.ones((Q, Q), dtype=bool))[:, :, None, None]
    Lmat = jnp.exp(jnp.where(mask, seg, -jnp.inf))
    cb = jnp.einsum('bclgn,bcsgn->bclsg', Cc, Bc)
    y_diag = jnp.einsum('bclsg,bclsge,bcsgep->bclgep', cb, Lmat, xdt)
    y_off = jnp.einsum('bclgn,bcgepn,bclge->bclgep', Cc, h_in, jnp.exp(a_cum))
    y = (y_diag + y_off).reshape(b, l, H, P)
    return y.astype(x.dtype), h_final


def ssd_mixer(u_lat, u_ctx, w_in, conv_w, conv_b, a_log, dt_bias, d_skip, norm_g, w_out, need_ctx_out):
    H, P, G, N = SSD_N_HEADS, SSD_HEAD_DIM, SSD_N_GROUPS, SSD_D_STATE
    A = -jnp.exp(a_log.astype(jnp.float32))

    def project(u):
        b, l, _ = u.shape
        zxbcdt = u @ w_in
        z = zxbcdt[..., :SSD_D_INNER]
        xbc = jax.nn.silu(dwconv_centred(zxbcdt[..., SSD_D_INNER:SSD_D_INNER + SSD_CONV_DIM], conv_w, conv_b))
        dt_raw = zxbcdt[..., SSD_D_INNER + SSD_CONV_DIM:]
        xs = xbc[..., :SSD_D_INNER].reshape(b, l, H, P)
        Bm = xbc[..., SSD_D_INNER:SSD_D_INNER + SSD_GN].reshape(b, l, G, N)
        Cm = xbc[..., SSD_D_INNER + SSD_GN:].reshape(b, l, G, N)
        dt = jax.nn.softplus(dt_raw.reshape(b, l, 2, H).astype(jnp.float32) + dt_bias.astype(jnp.float32))
        return z, xs, Bm, Cm, dt

    def flip(t, d):
        return t[:, ::-1] if d == 1 else t

    zc, xc, Bc, Cc, dtc = project(u_ctx)
    zl, xl, Bl, Cl, dtl = project(u_lat)
    b = u_lat.shape[0]
    h0 = jnp.zeros((b, G, H // G, P, N), jnp.float32)
    y_lat = d_skip[:, None] * xl
    y_ctx = d_skip[:, None] * xc if need_ctx_out else None
    for d in range(2):
        yc, hc = ssd_scan(flip(xc, d), flip(dtc[:, :, d], d), A[d], flip(Bc, d), flip(Cc, d), h0, need_ctx_out)
        yl, _ = ssd_scan(flip(xl, d), flip(dtl[:, :, d], d), A[d], flip(Bl, d), flip(Cl, d), hc, True)
        y_lat = y_lat + flip(yl, d)
        if need_ctx_out:
            y_ctx = y_ctx + flip(yc, d)

    def gate_norm_out(y, z):
        b_, l_ = y.shape[:2]
        gy = (y.reshape(b_, l_, SSD_D_INNER) * jax.nn.silu(z)).reshape(b_, l_, G, SSD_D_INNER // G)
        gy = rmsnorm(gy, norm_g.reshape(G, SSD_D_INNER // G))
        return gy.reshape(b_, l_, SSD_D_INNER) @ w_out

    out_lat = gate_norm_out(y_lat, zl)
    out_ctx = gate_norm_out(y_ctx, zc) if need_ctx_out else None
    return out_lat, out_ctx


def box_sum(v, w, axis):
    L = v.shape[axis]
    cs = jnp.cumsum(v, axis=axis)
    pad = [(0, 0)] * v.ndim
    pad[axis] = (1, 0)
    cs = jnp.pad(cs, pad)
    pos = jnp.arange(L)
    hi = jnp.minimum(pos + (w - w // 2), L)
    lo = jnp.maximum(pos - w // 2, 0)
    s = jnp.take(cs, hi, axis=axis) - jnp.take(cs, lo, axis=axis)
    return s, (hi - lo).astype(jnp.float32)


def pool_grid(v, w):
    b, l, C = v.shape
    rows = l // GRID_W
    v4 = v.astype(jnp.float32).reshape(b, rows, GRID_W, C)
    s, cnt_c = box_sum(v4, w, 2)
    s, cnt_r = box_sum(s, w, 1)
    mean = s / (cnt_r[:, None, None] * cnt_c[None, :, None])
    return mean.reshape(b, l, C).astype(v.dtype) - v


def pool_seq(v, w):
    s, cnt = box_sum(v.astype(jnp.float32), w, 1)
    return (s / cnt[None, :, None]).astype(v.dtype) - v


def pool_mixer(u_lat, u_ctx, w, bias, scale, need_ctx_out):
    def mix(u, pool_fn):
        b, l, _ = u.shape
        grp = u.reshape(b, l, POOL_GROUPS, POOL_GROUP_DIM)
        pooled = jnp.stack([pool_fn(grp[:, :, g], POOL_WINDOWS[g]) for g in range(POOL_GROUPS)], axis=2)
        y = jnp.einsum('blgc,gcd->blgd', pooled, w) + bias
        return y.reshape(b, l, D_MODEL) * scale

    out_lat = mix(u_lat, pool_grid)
    out_ctx = mix(u_ctx, pool_seq) if need_ctx_out else None
    return out_lat, out_ctx


def hyena_filter_fft(L, fw1, fb1, fw2, fb2, fw3, ffreq):
    f32 = jnp.float32
    pos = jnp.arange(L, dtype=f32)
    t = jnp.linspace(0.0, 1.0, L, dtype=f32)
    wpos = 2.0 * math.pi * pos / L
    f = jnp.linspace(1e-4, HY_BANDS - 1, HY_BANDS, dtype=f32)
    ang = wpos[:, None] * f[None, :]
    z = jnp.concatenate([t[:, None], jnp.cos(ang), -jnp.sin(ang)], axis=-1)
    h = jnp.sin(ffreq[0].astype(f32) * (z @ fw1.astype(f32) + fb1.astype(f32)))
    h = jnp.sin(ffreq[1].astype(f32) * (h @ fw2.astype(f32) + fb2.astype(f32)))
    h = (h @ fw3.astype(f32)).reshape(L, HY_ORDER, 2, D_MODEL)
    deltas = jnp.abs(jnp.linspace(HY_MIN_DECAY, HY_MAX_DECAY, D_MODEL, dtype=f32))
    h = h * jnp.exp(-t[:, None, None, None] * deltas)
    h = h * lax.rsqrt(jnp.sum(h * h, axis=(0, 2), keepdims=True) + EPS)
    kern = jnp.concatenate([h[:, :, 0], jnp.zeros((1, HY_ORDER, D_MODEL), f32), h[:0:-1, :, 1]], axis=0)
    return jnp.fft.rfft(kern, axis=0)


def fftconv(u, kf, bias):
    L = u.shape[1]
    uf = u.astype(jnp.float32)
    y = jnp.fft.irfft(jnp.fft.rfft(uf, n=2 * L, axis=1) * kf, n=2 * L, axis=1)[:, :L]
    return (y + uf * bias.astype(jnp.float32)).astype(u.dtype)


def hyena_mixer(u_lat, u_ctx, w_in, conv_w, conv_b, fw1, fb1, fw2, fb2, fw3, ffreq, hbias, w_out, need_ctx_out):
    def run(u):
        kf = hyena_filter_fft(u.shape[1], fw1, fb1, fw2, fb2, fw3, ffreq)
        p = dwconv_centred(u @ w_in, conv_w, conv_b)
        v, x1, x2 = jnp.split(p, 3, axis=-1)
        z = x1 * fftconv(v, kf[:, 0], hbias[0])
        y = x2 * fftconv(z, kf[:, 1], hbias[1])
        return y @ w_out

    out_lat = run(u_lat)
    out_ctx = run(u_ctx) if need_ctx_out else None
    return out_lat, out_ctx


def n_layers_of(kind):
    return len(range(kind, DEPTH, N_MIXERS))


def setup_inputs(seed: int = 0) -> dict:
    key = jax.random.key(seed)
    ks = jax.random.split(key, 32)
    f32 = jnp.float32

    def nrm(k, shape, scale):
        return jax.random.normal(k, shape, f32) * scale

    nA, nB, nC = n_layers_of(0), n_layers_of(1), n_layers_of(2)
    D, F = D_MODEL, D_FF
    H = SSD_N_HEADS
    dt0 = jnp.exp(jax.random.uniform(ks[12], (nA, 2, H), f32, math.log(1e-3), math.log(1e-1)))
    return {
        "x": nrm(ks[0], (BATCH, SEQ, D), 1.0),
        "c": nrm(ks[1], (BATCH, D), 1.0),
        "ctx": nrm(ks[2], (BATCH, CTX_LEN, D), 1.0),
        "c_ctx": nrm(ks[3], (D,), 1.0),
        "ada_w": nrm(ks[4], (DEPTH, D, N_MOD * D), 0.5 * D ** -0.5),
        "ada_b": nrm(ks[5], (DEPTH, N_MOD * D), 0.02),
        "norm_g": 1.0 + nrm(ks[6], (DEPTH, 3, D), 0.05),
        "ffn_w_gate": nrm(ks[7], (DEPTH, 2, D, F), D ** -0.5),
        "ffn_w_up": nrm(ks[8], (DEPTH, 2, D, F), D ** -0.5),
        "ffn_w_down": nrm(ks[9], (DEPTH, 2, F, D), F ** -0.5),
        "ssd_w_in": nrm(ks[10], (nA, D, SSD_IN_DIM), D ** -0.5),
        "ssd_conv_w": nrm(ks[11], (nA, SSD_CONV_W, SSD_CONV_DIM), SSD_CONV_W ** -0.5),
        "ssd_conv_b": nrm(ks[13], (nA, SSD_CONV_DIM), 0.02),
        "ssd_a_log": jnp.log(jax.random.uniform(ks[14], (nA, 2, H), f32, 1.0, 16.0)),
        "ssd_dt_bias": dt0 + jnp.log(-jnp.expm1(-dt0)),
        "ssd_d": 1.0 + nrm(ks[15], (nA, H), 0.1),
        "ssd_norm_g": 1.0 + nrm(ks[16], (nA, SSD_D_INNER), 0.05),
        "ssd_w_out": nrm(ks[17], (nA, SSD_D_INNER, D), SSD_D_INNER ** -0.5),
        "pool_w": nrm(ks[18], (nB, POOL_GROUPS, POOL_GROUP_DIM, POOL_GROUP_DIM), POOL_GROUP_DIM ** -0.5),
        "pool_b": nrm(ks[19], (nB, POOL_GROUPS, POOL_GROUP_DIM), 0.02),
        "pool_scale": 1.0 + nrm(ks[20], (nB, D), 0.1),
        "hy_w_in": nrm(ks[21], (nC, D, 3 * D), D ** -0.5),
        "hy_conv_w": nrm(ks[22], (nC, HY_SHORT_W, 3 * D), HY_SHORT_W ** -0.5),
        "hy_conv_b": nrm(ks[23], (nC, 3 * D), 0.02),
        "hy_filt_w1": nrm(ks[24], (nC, HY_EMB_DIM, HY_FILTER_HIDDEN), HY_EMB_DIM ** -0.5),
        "hy_filt_b1": nrm(ks[25], (nC, HY_FILTER_HIDDEN), 0.1),
        "hy_filt_w2": nrm(ks[26], (nC, HY_FILTER_HIDDEN, HY_FILTER_HIDDEN), HY_FILTER_HIDDEN ** -0.5),
        "hy_filt_b2": nrm(ks[27], (nC, HY_FILTER_HIDDEN), 0.1),
        "hy_filt_w3": nrm(ks[28], (nC, HY_FILTER_HIDDEN, HY_ORDER * 2 * D), HY_FILTER_HIDDEN ** -0.5),
        "hy_filt_freq": 1.0 + nrm(ks[29], (nC, 2, HY_FILTER_HIDDEN), 0.1),
        "hy_bias": nrm(ks[30], (nC, HY_ORDER, D), 0.1),
        "hy_w_out": nrm(ks[31], (nC, D, D), D ** -0.5),
        "final_g": 1.0 + nrm(jax.random.fold_in(key, 99), (D,), 0.05),
    }


def reference(x, c, ctx, c_ctx, ada_w, ada_b, norm_g, ffn_w_gate, ffn_w_up, ffn_w_down,
              ssd_w_in, ssd_conv_w, ssd_conv_b, ssd_a_log, ssd_dt_bias, ssd_d, ssd_norm_g, ssd_w_out,
              pool_w, pool_b, pool_scale,
              hy_w_in, hy_conv_w, hy_conv_b, hy_filt_w1, hy_filt_b1, hy_filt_w2, hy_filt_b2, hy_filt_w3,
              hy_filt_freq, hy_bias, hy_w_out, final_g):
    h = ctx
    sc = jax.nn.silu(c)
    scc = jax.nn.silu(c_ctx)
    for i in range(DEPTH):
        kind = i % N_MIXERS
        j = i // N_MIXERS
        last = i == DEPTH - 1
        ctx_in_needed = (not last) or kind == 0
        m = (sc @ ada_w[i] + ada_b[i]).reshape(-1, N_MOD, D_MODEL)[:, :, None, :]
        mc = (scc @ ada_w[i] + ada_b[i]).reshape(N_MOD, D_MODEL)[:, None, None, :]

        x = x + 0.5 * m[:, 2] * swiglu(modulate(x, norm_g[i, 0], m[:, 0], m[:, 1]),
                                       ffn_w_gate[i, 0], ffn_w_up[i, 0], ffn_w_down[i, 0])
        if ctx_in_needed:
            h = h + 0.5 * mc[2] * swiglu(modulate(h, norm_g[i, 0], mc[0], mc[1]),
                                         ffn_w_gate[i, 0], ffn_w_up[i, 0], ffn_w_down[i, 0])

        u = modulate(x, norm_g[i, 1], m[:, 3], m[:, 4])
        uc = modulate(h, norm_g[i, 1], mc[3], mc[4]) if ctx_in_needed else None
        if kind == 0:
            y, yc = ssd_mixer(u, uc, ssd_w_in[j], ssd_conv_w[j], ssd_conv_b[j], ssd_a_log[j], ssd_dt_bias[j],
                              ssd_d[j], ssd_norm_g[j], ssd_w_out[j], not last)
        elif kind == 1:
            y, yc = pool_mixer(u, uc, pool_w[j], pool_b[j], pool_scale[j], not last)
        else:
            y, yc = hyena_mixer(u, uc, hy_w_in[j], hy_conv_w[j], hy_conv_b[j], hy_filt_w1[j], hy_filt_b1[j],
                                hy_filt_w2[j], hy_filt_b2[j], hy_filt_w3[j], hy_filt_freq[j], hy_bias[j],
                                hy_w_out[j], not last)
        x = x + m[:, 5] * y
        if not last:
            h = h + mc[5] * yc

        x = x + 0.5 * m[:, 8] * swiglu(modulate(x, norm_g[i, 2], m[:, 6], m[:, 7]),
                                       ffn_w_gate[i, 1], ffn_w_up[i, 1], ffn_w_down[i, 1])
        if not last:
            h = h + 0.5 * mc[8] * swiglu(modulate(h, norm_g[i, 2], mc[6], mc[7]),
                                         ffn_w_gate[i, 1], ffn_w_up[i, 1], ffn_w_down[i, 1])
    return rmsnorm(x, final_g)
```

```cpp
#include <hip/hip_runtime.h>
#include <hip/hip_cooperative_groups.h>
#include <cstdio>
namespace cg = cooperative_groups;

namespace pg8 {
#define PG8_LAS __attribute__((address_space(3)))
typedef unsigned short bf16_t;
typedef short bf16x8 __attribute__((ext_vector_type(8)));
typedef float f32x4 __attribute__((ext_vector_type(4)));
typedef unsigned u32x4 __attribute__((ext_vector_type(4)));
constexpr int BM = 256, BK = 64, HALF = 128, HTB = HALF * BK * 2  , STAGE_BYTES = 8 * HTB, NXCD = 8, WGM = 8;

__host__ __device__ __forceinline__ int lds_byte(int r, int c) { const int st = (r >> 4) * 2 + (c >> 5), rr = r & 15, cc = c & 31, ob = rr * 64 + cc * 2; return st * 1024 + (ob ^ (((ob >> 9) & 1) << 5)); }
__host__ __device__ __forceinline__ void stage_rc(int b, int& R, int& C) { const int st = b / 1024, sb = b % 1024, swz = sb ^ (((sb >> 9) & 1) << 5); R = (st >> 1) * 16 + swz / 64; C = (st & 1) * 32 + (swz % 64) / 2; }
__host__ __device__ __forceinline__ int perm32(int rho) { const int n = rho >> 4, i = rho & 15; return 8 * (i >> 2) + 4 * n + (i & 3); }

struct Unit { int pm, pn; };
struct Gemm { const bf16_t* A; const bf16_t* Bt; int M, N, K; };
struct StaticOrder {
    int nM, nN, nwg, G, c;
    __host__ __device__ void init(int M, int N, int G_, int c_) { nM = M / BM; nN = N / BM; nwg = nM * nN; G = G_; c = c_; }
    __host__ __device__ bool next(int i, Unit& u) const {
        const long L = (long)i * G + c; if (L >= nwg) return false;
        int wgid = (int)L; { const int q = nwg / NXCD, r = nwg % NXCD, xcd = wgid % NXCD, off = wgid / NXCD; wgid = (xcd < r ? xcd * (q + 1) : r * (q + 1) + (xcd - r) * q) + off; }
        const int nig = WGM * nN, gid = wgid / nig, fm = gid * WGM, gsz = (nM - fm) < WGM ? (nM - fm) : WGM;
        u.pm = fm + ((wgid % nig) % gsz); u.pn = (wgid % nig) / gsz; return true;
    }
    __device__ __forceinline__ void a_ready(const Unit&) const {}
    __device__ __forceinline__ void done(const Unit&) const {}
};
__device__ __forceinline__ unsigned cvt_pk_bf16(float lo, float hi) { unsigned r; asm volatile("v_cvt_pk_bf16_f32 %0, %1, %2" : "=v"(r) : "v"(lo), "v"(hi)); return r; }
template <class Epi, class Sched>
__device__ __forceinline__ void gemm_phase(PG8_LAS unsigned char* lds, const Gemm g, const Sched S, const Epi E) {
    int tid_ = threadIdx.x; asm volatile("" : "+v"(tid_));
    const int tid = tid_, wid = __builtin_amdgcn_readfirstlane(tid >> 6), lane = tid & 63, wr = wid >> 2, wc = wid & 3, fr = lane & 15, fq = lane >> 4;
    const int K = g.K, nt = K / BK;
    unsigned voffA[2], voffB[2];
#pragma unroll
    for (int i = 0; i < 2; ++i) { int R, C; stage_rc(tid * 16 + i * 8192, R, C); const int Rb = Epi::PERM ? ((R & ~31) + perm32(R & 31)) : R;
        voffA[i] = (unsigned)(R * K + C) * 2u; voffB[i] = (unsigned)(Rb * K + C) * 2u; }
    const size_t kstep = (size_t)(BK * 2);
    const size_t hstep = (size_t)HALF * K * 2;
    const size_t tstep = 2 * hstep;
    const unsigned ldsw = (unsigned)wid * 1024u;
    const int aoff = lds_byte(wr * 64 + fr, fq * 8), boff = lds_byte(wc * 32 + fr, fq * 8);
#define PG8_SA(b, h) (((b) * 2 + (h)) * HTB)
#define PG8_SB(b, h) ((4 + (b) * 2 + (h)) * HTB)
#define PG8_STAGE(bufoff, gbase, voff) do { _Pragma("unroll") for (int _i = 0; _i < 2; ++_i) \
        __builtin_amdgcn_global_load_lds((const unsigned*)((const char*)(gbase) + (voff)[_i]), (PG8_LAS unsigned*)(lds + (bufoff) + ldsw + _i * 8192), 16, 0, 0); } while (0)
#define PG8_LDA(dst, b, h) do { _Pragma("unroll") for (int m = 0; m < 4; ++m) _Pragma("unroll") for (int k = 0; k < 2; ++k) dst[m][k] = *(const PG8_LAS bf16x8*)(lds + PG8_SA(b, h) + aoff + m * 2048 + k * 1024); } while (0)
#define PG8_LDB(dst, b, h) do { _Pragma("unroll") for (int n = 0; n < 2; ++n) _Pragma("unroll") for (int k = 0; k < 2; ++k) dst[n][k] = *(const PG8_LAS bf16x8*)(lds + PG8_SB(b, h) + boff + n * 2048 + k * 1024); } while (0)
#define PG8_MMA(ai, bj, At, Bt) do { __builtin_amdgcn_s_setprio(1); _Pragma("unroll") for (int m = 0; m < 4; ++m) _Pragma("unroll") for (int n = 0; n < 2; ++n) _Pragma("unroll") for (int k = 0; k < 2; ++k) \
        acc[ai][bj][m][n] = __builtin_amdgcn_mfma_f32_16x16x32_bf16(Bt[n][k], At[m][k], acc[ai][bj][m][n], 0, 0, 0); __builtin_amdgcn_s_setprio(0); } while (0)
#define PG8_WAIT_V(n) asm volatile("s_waitcnt vmcnt(" #n ")" ::: "memory")
#define PG8_WAIT_L(n) asm volatile("s_waitcnt lgkmcnt(" #n ")" ::: "memory")
#define PG8_BAR __builtin_amdgcn_s_barrier()
#define PG8_SCHED __builtin_amdgcn_sched_barrier(0)
    Unit cur, nxt; int ui = 0;
    if (!S.next(0, cur)) return;
    f32x4 acc[2][2][4][2];
#pragma unroll
    for (int a = 0; a < 2; ++a)
#pragma unroll
        for (int b = 0; b < 2; ++b)
#pragma unroll
            for (int m = 0; m < 4; ++m)
#pragma unroll
                for (int n = 0; n < 2; ++n) acc[a][b][m][n] = (f32x4){0.f, 0.f, 0.f, 0.f};
    bf16x8 At[4][2], B0[2][2], B1[2][2];
    const char* cA = (const char*)g.A + (size_t)cur.pm * tstep; const char* cB = (const char*)g.Bt + (size_t)cur.pn * tstep;
    S.a_ready(cur);
    PG8_STAGE(PG8_SB(0, 0), cB, voffB); PG8_STAGE(PG8_SA(0, 0), cA, voffA); PG8_STAGE(PG8_SB(0, 1), cB + hstep, voffB); PG8_STAGE(PG8_SA(0, 1), cA + hstep, voffA);
    if (wr == 1) PG8_BAR;
    PG8_WAIT_V(4); PG8_BAR;
    PG8_STAGE(PG8_SB(1, 0), cB + kstep, voffB); PG8_STAGE(PG8_SA(1, 0), cA + kstep, voffA); PG8_STAGE(PG8_SB(1, 1), cB + hstep + kstep, voffB);
    PG8_WAIT_V(6); PG8_BAR;
    for (;;) {
        const bool has_next = S.next(ui + 1, nxt);
        const char* nA = has_next ? (const char*)g.A + (size_t)nxt.pm * tstep : cA; const char* nB = has_next ? (const char*)g.Bt + (size_t)nxt.pn * tstep : cB;
        for (int t = 0; t < nt; t += 2) {
            const bool last = (t == nt - 2);
            const char* a1 = cA + (size_t)(t + 1) * kstep;
            const char* a2 = last ? nA : cA + (size_t)(t + 2) * kstep; const char* b2 = last ? nB : cB + (size_t)(t + 2) * kstep;
            const char* a3 = a2 + kstep; const char* b3 = b2 + kstep;
            if (last && has_next) S.a_ready(nxt);
            PG8_LDB(B0, 0, 0); PG8_SCHED; PG8_LDA(At, 0, 0); PG8_STAGE(PG8_SA(1, 1), a1 + hstep, voffA);
            PG8_WAIT_L(8); PG8_BAR; PG8_WAIT_L(0); PG8_MMA(0, 0, At, B0); PG8_BAR; PG8_SCHED;
            PG8_LDB(B1, 0, 1); PG8_STAGE(PG8_SB(0, 0), b2, voffB);
            PG8_BAR; PG8_WAIT_L(0); PG8_MMA(0, 1, At, B1); PG8_BAR;
            PG8_LDA(At, 0, 1); PG8_STAGE(PG8_SA(0, 0), a2, voffA);
            PG8_BAR; PG8_WAIT_L(0); PG8_MMA(1, 0, At, B0); PG8_BAR; PG8_SCHED;
            PG8_STAGE(PG8_SB(0, 1), b2 + hstep, voffB);
            PG8_WAIT_V(6); PG8_BAR; PG8_MMA(1, 1, At, B1); PG8_BAR;
            PG8_LDB(B0, 1, 0); PG8_SCHED; PG8_LDA(At, 1, 0); PG8_STAGE(PG8_SA(0, 1), a2 + hstep, voffA);
            PG8_WAIT_L(8); PG8_BAR; PG8_WAIT_L(0); PG8_MMA(0, 0, At, B0); PG8_BAR; PG8_SCHED;
            PG8_LDB(B1, 1, 1); PG8_STAGE(PG8_SB(1, 0), b3, voffB);
            PG8_BAR; PG8_WAIT_L(0); PG8_MMA(0, 1, At, B1); PG8_BAR;
            PG8_LDA(At, 1, 1); PG8_STAGE(PG8_SA(1, 0), a3, voffA);
            PG8_BAR; PG8_WAIT_L(0); PG8_MMA(1, 0, At, B0); PG8_BAR; PG8_SCHED;
            PG8_STAGE(PG8_SB(1, 1), b3 + hstep, voffB);
            PG8_WAIT_V(6); PG8_BAR; PG8_MMA(1, 1, At, B1); PG8_BAR;
        }
        if constexpr (!Epi::AFTER_DRAIN) { E(acc, cur, wr, wc, fr, fq); S.done(cur); }
        if (!has_next) break;
#pragma unroll
        for (int a = 0; a < 2; ++a)
#pragma unroll
            for (int b = 0; b < 2; ++b)
#pragma unroll
                for (int m = 0; m < 4; ++m)
#pragma unroll
                    for (int n = 0; n < 2; ++n) acc[a][b][m][n] = (f32x4){0.f, 0.f, 0.f, 0.f};
        cur = nxt; cA = nA; cB = nB; ++ui;
    }
    PG8_WAIT_V(0);
    if (wr == 0) PG8_BAR;
    PG8_BAR;
    if constexpr (Epi::AFTER_DRAIN) { E.fused(acc, cur, wr, wc, fr, fq, lds, wid, lane); S.done(cur); }
#undef PG8_SA
#undef PG8_SB
#undef PG8_STAGE
#undef PG8_LDA
#undef PG8_LDB
#undef PG8_MMA
#undef PG8_WAIT_V
#undef PG8_WAIT_L
#undef PG8_BAR
#undef PG8_SCHED
}
}

using namespace pg8;
typedef unsigned short u16;
typedef unsigned u32;
typedef u32 u32x2 __attribute__((ext_vector_type(2)));
typedef float f32x2v __attribute__((ext_vector_type(2)));

constexpr int ML = 32768, MCX = 1024, MT = 33792, FF = 2816;
constexpr int LDS_BYTES = 159744;
constexpr size_t OFF_U = 0, SZ_U = (size_t)MT * 1024 * 2;
constexpr size_t OFF_BIG = OFF_U + SZ_U, SZ_BIG = (size_t)MT * 7168 * 2;
constexpr size_t SZ_WGU = (size_t)5632 * 1024 * 2, SZ_WD = (size_t)1024 * 2816 * 2;
constexpr size_t OFF_WGU0 = OFF_BIG + SZ_BIG, OFF_WD0 = OFF_WGU0 + SZ_WGU, OFF_WGU1 = OFF_WD0 + SZ_WD, OFF_WD1 = OFF_WGU1 + SZ_WGU;
constexpr size_t OFF_WM1 = OFF_WD1 + SZ_WD, SZ_WM1 = (size_t)5376 * 1024 * 2, OFF_WM2 = OFF_WM1 + SZ_WM1, SZ_WM2 = (size_t)2048 * 1024 * 2;
constexpr size_t OFF_MOD = OFF_WM2 + SZ_WM2, SZ_MOD = (size_t)4 * 5 * 9216 * 4;
constexpr size_t OFF_HC = OFF_MOD + SZ_MOD, SZ_HC = (size_t)1024 * 1024 * 4;
constexpr size_t OFF_DT = OFF_HC + SZ_HC, SZ_DT = (size_t)MT * 64 * 4;
constexpr size_t OFF_HID2 = OFF_DT + SZ_DT, SZ_HID2 = (size_t)8192 * 64 * 4;
constexpr size_t OFF_HID2C = OFF_HID2 + SZ_HID2, SZ_HID2C = (size_t)256 * 64 * 4;
constexpr size_t OFF_CONST = OFF_HID2C + SZ_HID2C;
constexpr size_t WS_END = OFF_CONST + 8192;
constexpr size_t OFF_HID = OFF_BIG;
constexpr size_t OFF_Z = OFF_BIG, OFF_XBC = OFF_BIG + (size_t)MT * 2048 * 2, OFF_Y = OFF_BIG + (size_t)MT * 5120 * 2;
constexpr size_t OFF_POOLED = OFF_BIG;
constexpr size_t OFF_PT = OFF_BIG, OFF_YT = OFF_BIG + (size_t)3072 * MT * 2, OFF_KF = OFF_BIG + (size_t)4096 * MT * 2;
constexpr size_t OFF_ZS = OFF_KF + (size_t)256 * 4 * 8200 * 8;
constexpr int KF_STRIDE = 8200;
constexpr size_t OFF_PART = OFF_BIG;

__device__ __forceinline__ int otid() { int t = threadIdx.x; asm volatile("" : "+v"(t)); return t; }
struct Params { const float* in[33]; float* out; unsigned char* ws; };

__device__ __forceinline__ u16 f2bf(float f) { u32 u = __float_as_uint(f); u += 0x7FFFu + ((u >> 16) & 1u); return (u16)(u >> 16); }
__device__ __forceinline__ float bf2f(u16 b) { return __uint_as_float(((u32)b) << 16); }
__device__ __forceinline__ u32 pack2(float lo, float hi) { return (u32)f2bf(lo) | ((u32)f2bf(hi) << 16); }
__device__ __forceinline__ float bflo(u32 v) { return __uint_as_float(v << 16); }
__device__ __forceinline__ float bfhi(u32 v) { return __uint_as_float(v & 0xFFFF0000u); }
__device__ __forceinline__ float silu_f(float x) { return x / (1.f + __expf(-x)); }
__device__ __forceinline__ float wave_sum(float v) {
#pragma unroll
    for (int o = 32; o >= 1; o >>= 1) v += __shfl_xor(v, o);
    return v;
}

struct EpiFFN1 {
    static constexpr bool PERM = true, AFTER_DRAIN = false;
    u16* H;
    __device__ __forceinline__ void operator()(const f32x4 (&acc)[2][2][4][2], const Unit& u, int wr, int wc, int fr, int fq) const {
        const int row0 = u.pm * BM + wr * 64 + fr, col0 = u.pn * 128 + wc * 32 + 8 * fq;
#pragma unroll
        for (int ai = 0; ai < 2; ++ai)
#pragma unroll
            for (int m = 0; m < 4; ++m) {
                const f32x4 g0 = acc[ai][0][m][0], g1 = acc[ai][0][m][1], u0 = acc[ai][1][m][0], u1 = acc[ai][1][m][1];
                u32x4 o;
                o[0] = pack2(silu_f(g0[0]) * u0[0], silu_f(g0[1]) * u0[1]); o[1] = pack2(silu_f(g0[2]) * u0[2], silu_f(g0[3]) * u0[3]);
                o[2] = pack2(silu_f(g1[0]) * u1[0], silu_f(g1[1]) * u1[1]); o[3] = pack2(silu_f(g1[2]) * u1[2], silu_f(g1[3]) * u1[3]);
                *(u32x4*)(H + (size_t)(row0 + ai * HALF + m * 16) * FF + col0) = o;
            }
    }
};
struct EpiResid {
    static constexpr bool PERM = false, AFTER_DRAIN = false;
    float* X; float* Hc; const float* gate0; const float* bias; const float* cscale; float gmul; float pad_;
    __device__ __forceinline__ void operator()(const f32x4 (&acc)[2][2][4][2], const Unit& u, int wr, int wc, int fr, int fq) const {
        const int b = u.pm < 128 ? (u.pm >> 5) : 4;
        const float* gate = gate0 + b * 9216;
        const int row0 = u.pm * BM + wr * 64 + fr, col0 = u.pn * BM + wc * 32 + 4 * fq;
#pragma unroll
        for (int bj = 0; bj < 2; ++bj)
#pragma unroll
            for (int n = 0; n < 2; ++n) { const int c = col0 + bj * HALF + n * 16;
                const f32x4 gv = *(const f32x4*)(gate + c) * gmul;
                const f32x4 bv = *(const f32x4*)(bias + c);
                const f32x4 sv = *(const f32x4*)(cscale + c);
#pragma unroll
                for (int ai = 0; ai < 2; ++ai)
#pragma unroll
                    for (int m = 0; m < 4; ++m) { const int row = row0 + ai * HALF + m * 16;
                        float* xr = (row < ML ? X + (size_t)row * 1024 : Hc + (size_t)(row - ML) * 1024) + c;
                        f32x4* px = (f32x4*)xr;
                        const f32x4 v = (acc[ai][bj][m][n] + bv) * sv;
                        *px = *px + gv * v; } }
    }
};
struct EpiSSDin {
    static constexpr bool PERM = true, AFTER_DRAIN = false;
    u16* Z; u16* XBC; float* DT;
    __device__ __forceinline__ void operator()(const f32x4 (&acc)[2][2][4][2], const Unit& u, int wr, int wc, int fr, int fq) const {
        const int row0 = u.pm * BM + wr * 64 + fr, cw = wc * 32 + 8 * fq;
        if (u.pn < 20) {
            u16* base; int ld;
            if (u.pn < 8) { base = Z + u.pn * 256; ld = 2048; } else { base = XBC + (u.pn - 8) * 256; ld = 3072; }
#pragma unroll
            for (int ai = 0; ai < 2; ++ai)
#pragma unroll
                for (int m = 0; m < 4; ++m) { u16* rp = base + (size_t)(row0 + ai * HALF + m * 16) * ld + cw;
#pragma unroll
                    for (int bj = 0; bj < 2; ++bj) { const f32x4 v0 = acc[ai][bj][m][0], v1 = acc[ai][bj][m][1]; u32x4 o;
                        o[0] = pack2(v0[0], v0[1]); o[1] = pack2(v0[2], v0[3]); o[2] = pack2(v1[0], v1[1]); o[3] = pack2(v1[2], v1[3]);
                        *(u32x4*)(rp + bj * HALF) = o; } }
        } else if (wc < 2) {
#pragma unroll
            for (int ai = 0; ai < 2; ++ai)
#pragma unroll
                for (int m = 0; m < 4; ++m) { float* rp = DT + (size_t)(row0 + ai * HALF + m * 16) * 64 + cw;
                    *(f32x4*)(rp) = acc[ai][0][m][0]; *(f32x4*)(rp + 4) = acc[ai][0][m][1]; }
        }
    }
};
struct EpiBf16T {
    static constexpr bool PERM = true, AFTER_DRAIN = false;
    u16* O; int ldc;
    __device__ __forceinline__ void operator()(const f32x4 (&acc)[2][2][4][2], const Unit& u, int wr, int wc, int fr, int fq) const {
        const int row0 = u.pm * BM + wr * 64 + fr, col0 = u.pn * BM + wc * 32 + 8 * fq;
#pragma unroll
        for (int ai = 0; ai < 2; ++ai)
#pragma unroll
            for (int m = 0; m < 4; ++m) { u16* rp = O + (size_t)(row0 + ai * HALF + m * 16) * ldc + col0;
#pragma unroll
                for (int bj = 0; bj < 2; ++bj) { const f32x4 v0 = acc[ai][bj][m][0], v1 = acc[ai][bj][m][1]; u32x4 o;
                    o[0] = pack2(v0[0], v0[1]); o[1] = pack2(v0[2], v0[3]); o[2] = pack2(v1[0], v1[1]); o[3] = pack2(v1[2], v1[3]);
                    *(u32x4*)(rp + bj * HALF) = o; } }
    }
};
template <class Epi> __device__ __forceinline__ void run_gemm(unsigned char* shm, const u16* A, const u16* Bt, int M, int N, int K, const Epi E) {
    StaticOrder S; S.init(M, N, (int)gridDim.x, (int)blockIdx.x);
    Gemm g; g.A = A; g.Bt = Bt; g.M = M; g.N = N; g.K = K;
    gemm_phase<Epi, StaticOrder>((PG8_LAS unsigned char*)shm, g, S, E);
}

__device__ void phase_setup(const Params& p, unsigned char* shm) {
    const int tid = otid();
    float* fl = (float*)shm;
    if (blockIdx.x == 0) { float* cz = (float*)(p.ws + OFF_CONST); for (int i = tid; i < 2048; i += 512) cz[i] = i < 1024 ? 0.f : 1.f; }
    {
        const float4* sx = (const float4*)p.in[0]; float4* dx = (float4*)p.out;
        const size_t n4 = (size_t)ML * 1024 / 4, stride = (size_t)gridDim.x * 512;
        for (size_t i = (size_t)blockIdx.x * 512 + tid; i < n4; i += stride) dx[i] = sx[i];
        const float4* sc = (const float4*)p.in[2]; float4* dc = (float4*)(p.ws + OFF_HC);
        const size_t m4 = (size_t)MCX * 1024 / 4;
        for (size_t i = (size_t)blockIdx.x * 512 + tid; i < m4; i += stride) dc[i] = sc[i];
    }
    {
        const float* cvec = p.in[1]; const float* cctx = p.in[3]; const float* aw = p.in[4];
        float* part = (float*)(p.ws + OFF_PART);
        for (int it = blockIdx.x; it < 576; it += gridDim.x) {
            const int layer = it / 144, rem = it % 144, cc = rem >> 3, kc = rem & 7;
            __syncthreads();
            for (int i = tid; i < 640; i += 512) { const int r = i >> 7, k = i & 127; const float v = r < 4 ? cvec[r * 1024 + kc * 128 + k] : cctx[kc * 128 + k]; fl[i] = silu_f(v); }
            __syncthreads();
            const int col = cc * 512 + tid;
            float a0 = 0.f, a1 = 0.f, a2 = 0.f, a3 = 0.f, a4 = 0.f;
            const float* wp = aw + ((size_t)layer * 1024 + kc * 128) * 9216 + col;
#pragma unroll 8
            for (int k = 0; k < 128; ++k) { const float w = wp[(size_t)k * 9216]; a0 += fl[k] * w; a1 += fl[128 + k] * w; a2 += fl[256 + k] * w; a3 += fl[384 + k] * w; a4 += fl[512 + k] * w; }
            float* po = part + ((size_t)(kc * 4 + layer) * 5) * 9216 + col;
            po[0] = a0; po[9216] = a1; po[2 * 9216] = a2; po[3 * 9216] = a3; po[4 * 9216] = a4;
        }
    }
    {
        const float* fw1 = p.in[24]; const float* fb1 = p.in[25]; const float* fw2 = p.in[26]; const float* fb2 = p.in[27]; const float* fq = p.in[29];
        float* zs = fl + 1024; float* h1s = fl + 1024 + 8 * 36;
        const int pl = tid >> 6, jx = tid & 63;
        for (int grp = blockIdx.x; grp < 1056; grp += gridDim.x) {
            int L, pos; float* outp;
            if (grp < 1024) { L = 8192; pos = grp * 8 + pl; outp = (float*)(p.ws + OFF_HID2) + (size_t)pos * 64; }
            else { L = 256; pos = (grp - 1024) * 8 + pl; outp = (float*)(p.ws + OFF_HID2C) + (size_t)pos * 64; }
            __syncthreads();
            if (jx < 33) {
                float zv;
                if (jx == 0) zv = (float)pos / (float)(L - 1);
                else { const int k = (jx - 1) & 15; const float f = 1e-4f + (float)k * ((15.0f - 1e-4f) / 15.0f);
                    const float wpos = (6.283185307179586f * (float)pos) / (float)L; const float ang = wpos * f;
                    zv = jx <= 16 ? cosf(ang) : -sinf(ang); }
                zs[pl * 36 + jx] = zv;
            }
            __syncthreads();
            float a = fb1[jx];
            for (int i = 0; i < 33; ++i) a += zs[pl * 36 + i] * fw1[i * 64 + jx];
            h1s[pl * 64 + jx] = sinf(fq[jx] * a);
            __syncthreads();
            float a2 = fb2[jx];
            for (int i = 0; i < 64; ++i) a2 += h1s[pl * 64 + i] * fw2[i * 64 + jx];
            outp[jx] = sinf(fq[64 + jx] * a2);
        }
    }
}
__device__ void phase_modreduce(const Params& p) {
    const float* part = (const float*)(p.ws + OFF_PART); const float* ab = p.in[5]; float* mod = (float*)(p.ws + OFF_MOD);
    for (int idx = blockIdx.x * 512 + otid(); idx < 4 * 5 * 9216; idx += gridDim.x * 512) {
        const int layer = idx / 46080, col = idx % 9216;
        float s = ab[layer * 9216 + col];
#pragma unroll
        for (int kc = 0; kc < 8; ++kc) s += part[(size_t)kc * 184320 + idx];
        mod[idx] = s;
    }
}

__device__ void convert_job(const float* src, int K, int N, int lds_, u16* dst, int ldd, int nmul, int noff, int koff, unsigned char* shm) {
    float* tile = (float*)shm;
    const int tid = otid(), tk = K >> 6, tn = N >> 6, nt = tk * tn;
    for (int t = blockIdx.x; t < nt; t += gridDim.x) {
        const int k0 = (t / tn) << 6, n0 = (t % tn) << 6;
        __syncthreads();
#pragma unroll
        for (int r = 0; r < 8; ++r) { const int i = (tid >> 6) + 8 * r, jn = tid & 63; tile[i * 65 + jn] = src[(size_t)(k0 + i) * lds_ + n0 + jn]; }
        __syncthreads();
#pragma unroll
        for (int r = 0; r < 4; ++r) { const int jn = (tid >> 5) + 16 * r, ik = (tid & 31) * 2; const int n = n0 + jn;
            const int nd = (n >> 7) * nmul + noff + (n & 127);
            *(u32*)(dst + (size_t)nd * ldd + koff + k0 + ik) = pack2(tile[ik * 65 + jn], tile[(ik + 1) * 65 + jn]); }
    }
}
__device__ void convert_layer(const Params& p, int layer, unsigned char* shm) {
    const int kind = layer % 3;
    for (int f = 0; f < 2; ++f) {
        const size_t wo = (size_t)(layer * 2 + f) * 1024 * FF;
        u16* wgu = (u16*)(p.ws + (f ? OFF_WGU1 : OFF_WGU0)); u16* wd = (u16*)(p.ws + (f ? OFF_WD1 : OFF_WD0));
        convert_job(p.in[7] + wo, 1024, FF, FF, wgu, 1024, 256, 0, 0, shm);
        convert_job(p.in[8] + wo, 1024, FF, FF, wgu, 1024, 256, 128, 0, shm);
        convert_job(p.in[9] + wo, FF, 1024, 1024, wd, FF, 128, 0, 0, shm);
    }
    u16* wm1 = (u16*)(p.ws + OFF_WM1); u16* wm2 = (u16*)(p.ws + OFF_WM2);
    if (kind == 0) { const int j = layer / 3;
        convert_job(p.in[10] + (size_t)j * 1024 * 5184, 1024, 5184, 5184, wm1, 1024, 128, 0, 0, shm);
        convert_job(p.in[17] + (size_t)j * 2048 * 1024, 2048, 1024, 1024, wm2, 2048, 128, 0, 0, shm);
    } else if (kind == 1) {
        for (int t = blockIdx.x; t < 192; t += gridDim.x) {
            const int ob = t >> 4, piece = t & 15; const int gr = ob / 3, gcr = ob % 3; const int gc = gcr + (gcr >= gr ? 1 : 0);
            const int tid = otid(); const int r = piece * 16 + (tid >> 5), c8 = (tid & 31) * 8;
            *(u32x4*)(wm1 + (size_t)(gr * 256 + r) * 1024 + gc * 256 + c8) = (u32x4){0u, 0u, 0u, 0u};
        }
        for (int g = 0; g < 4; ++g) convert_job(p.in[18] + (size_t)g * 65536, 256, 256, 256, wm1, 1024, 128, g * 256, g * 256, shm);
    } else {
        convert_job(p.in[21], 1024, 3072, 3072, wm1, 1024, 128, 0, 0, shm);
        convert_job(p.in[31], 1024, 1024, 1024, wm2, 1024, 128, 0, 0, shm);
    }
}

__device__ void phase_modulate(const Params& p, int layer, int which) {
    const int lane = otid() & 63, gw = blockIdx.x * 8 + (otid() >> 6), nw = gridDim.x * 8;
    const float* g = p.in[6] + (size_t)(layer * 3 + which) * 1024;
    const float* mod = (const float*)(p.ws + OFF_MOD) + (size_t)layer * 5 * 9216;
    const float* Hc = (const float*)(p.ws + OFF_HC); u16* U = (u16*)(p.ws + OFF_U);
    for (int row = gw; row < MT; row += nw) {
        const int b = row < ML ? (row >> 13) : 4;
        const float* xr = row < ML ? p.out + (size_t)row * 1024 : Hc + (size_t)(row - ML) * 1024;
        const float* sh = mod + (size_t)b * 9216 + (3 * which) * 1024; const float* sc = sh + 1024;
        float4 v[4]; float ss = 0.f;
#pragma unroll
        for (int k = 0; k < 4; ++k) { v[k] = *(const float4*)(xr + k * 256 + lane * 4); ss += v[k].x * v[k].x + v[k].y * v[k].y + v[k].z * v[k].z + v[k].w * v[k].w; }
        ss = wave_sum(ss);
        const float rstd = rsqrtf(ss * (1.f / 1024.f) + 1e-6f);
#pragma unroll
        for (int k = 0; k < 4; ++k) { const int c = k * 256 + lane * 4;
            const float4 g4 = *(const float4*)(g + c), s4 = *(const float4*)(sc + c), h4 = *(const float4*)(sh + c);
            u32x2 o;
            o[0] = pack2(v[k].x * rstd * g4.x * (1.f + s4.x) + h4.x, v[k].y * rstd * g4.y * (1.f + s4.y) + h4.y);
            o[1] = pack2(v[k].z * rstd * g4.z * (1.f + s4.z) + h4.z, v[k].w * rstd * g4.w * (1.f + s4.w) + h4.w);
            *(u32x2*)(U + (size_t)row * 1024 + c) = o; }
    }
}
__device__ void phase_final(const Params& p) {
    const int lane = otid() & 63, gw = blockIdx.x * 8 + (otid() >> 6), nw = gridDim.x * 8;
    const float* g = p.in[32];
    for (int row = gw; row < ML; row += nw) {
        float* xr = p.out + (size_t)row * 1024;
        float4 v[4]; float ss = 0.f;
#pragma unroll
        for (int k = 0; k < 4; ++k) { v[k] = *(const float4*)(xr + k * 256 + lane * 4); ss += v[k].x * v[k].x + v[k].y * v[k].y + v[k].z * v[k].z + v[k].w * v[k].w; }
        ss = wave_sum(ss);
        const float rstd = rsqrtf(ss * (1.f / 1024.f) + 1e-6f);
#pragma unroll
        for (int k = 0; k < 4; ++k) { const int c = k * 256 + lane * 4; const float4 g4 = *(const float4*)(g + c);
            float4 o; o.x = v[k].x * rstd * g4.x; o.y = v[k].y * rstd * g4.y; o.z = v[k].z * rstd * g4.z; o.w = v[k].w * rstd * g4.w;
            *(float4*)(xr + c) = o; }
    }
}

__device__ __forceinline__ int swz(int row, int col) { return row * 256 + ((((col >> 3) ^ (row & 15))) << 4) + ((col & 7) << 1); }
__device__ __forceinline__ void unpack8(const u32x4 v, float (&f)[8]) {
    f[0] = bflo(v[0]); f[1] = bfhi(v[0]); f[2] = bflo(v[1]); f[3] = bfhi(v[1]); f[4] = bflo(v[2]); f[5] = bfhi(v[2]); f[6] = bflo(v[3]); f[7] = bfhi(v[3]);
}
__device__ void phase_ssd_scan(const Params& p, int j, unsigned char* lds) {
    const int tid0 = otid(), wave = __builtin_amdgcn_readfirstlane(tid0 >> 6);
    unsigned char* Cs = lds; unsigned char* Bs = lds + 32768; unsigned char* BTs = lds + 65536; unsigned char* Gs = lds + 98304;
    unsigned char* XTs = lds + 131072; unsigned char* Hs = lds + 139264;
    float* wts = (float*)(lds + 147456);
    float* cum = wts + 1728; float* dtv = cum + 128; float* wtot = dtv + 128;
    const u16* XBC = (const u16*)(p.ws + OFF_XBC); const float* DT = (const float*)(p.ws + OFF_DT); u16* Y = (u16*)(p.ws + OFF_Y);
    const float* conv_w = p.in[11] + (size_t)j * 5 * 3072; const float* conv_b = p.in[12] + (size_t)j * 3072;
    for (int item = blockIdx.x; item < 256; item += gridDim.x) {
        const int b = item >> 6, h = (item >> 1) & 31, ph = item & 1, g = h >> 3;
        const int xc0 = h * 64 + ph * 32, bc0 = 2048 + g * 128, cc0 = 2560 + g * 128;
        __syncthreads();
        for (int i = tid0; i < 1728; i += 512) {
            float v;
            if (i < 768) { const int k = i >> 7, n = i & 127; v = k < 5 ? conv_w[k * 3072 + bc0 + n] : conv_b[bc0 + n]; }
            else if (i < 1536) { const int ii = i - 768; const int k = ii >> 7, n = ii & 127; v = k < 5 ? conv_w[k * 3072 + cc0 + n] : conv_b[cc0 + n]; }
            else { const int ii = i - 1536; const int k = ii >> 5, n = ii & 31; v = k < 5 ? conv_w[k * 3072 + xc0 + n] : conv_b[xc0 + n]; }
            wts[i] = v;
        }
        const float Dh = p.in[15][j * 32 + h];
        for (int d = 0; d < 2; ++d) {
            const float Aneg = -__expf(p.in[13][(j * 2 + d) * 32 + h]); const float dtb = p.in[14][(j * 2 + d) * 32 + h];
            f32x4 hreg[2] = {(f32x4){0.f, 0.f, 0.f, 0.f}, (f32x4){0.f, 0.f, 0.f, 0.f}};
            __syncthreads();
            *(u32x4*)(Hs + tid0 * 16) = (u32x4){0u, 0u, 0u, 0u};
            for (int ci = 0; ci < 66; ++ci) {
                int tid = tid0; asm volatile("" : "+v"(tid));
                const int lane = tid & 63, fr = lane & 15, fq = lane >> 4;
                int row0, seg_lo, seg_hi;
                if (ci < 2) { const int cc = d == 0 ? ci : 1 - ci; seg_lo = ML + b * 256; seg_hi = seg_lo + 256; row0 = seg_lo + cc * 128; }
                else { int lc = ci - 2; if (d) lc = 63 - lc; seg_lo = b * 8192; seg_hi = seg_lo + 8192; row0 = seg_lo + lc * 128; }
                __syncthreads();
                float a_l = 0.f, pre = 0.f;
                if (tid < 128) {
                    const float raw = DT[(size_t)(row0 + tid) * 64 + d * 32 + h] + dtb;
                    const float dt = raw > 20.f ? raw : log1pf(__expf(raw));
                    dtv[tid] = dt; a_l = dt * Aneg; pre = a_l;
#pragma unroll
                    for (int o = 1; o < 64; o <<= 1) { const float t = __shfl_up(pre, o); if (lane >= o) pre += t; }
                    if (lane == 63) wtot[wave] = pre;
                }
                __syncthreads();
                const float total = wtot[0] + wtot[1];
                if (tid < 128) { const float P = pre + (wave == 1 ? wtot[0] : 0.f); cum[tid] = d == 0 ? P : (total - P + a_l); }
                __syncthreads();
                {
                    const int co = tid & 15, rg = tid >> 4;
#pragma unroll
                    for (int which = 0; which < 2; ++which) {
                        const float* wb = wts + which * 768; const int colbase = (which == 0 ? bc0 : cc0) + co * 8;
                        u32x4 in[8];
#pragma unroll
                        for (int i = 0; i < 8; ++i) { const int gr = row0 + rg * 4 - 2 + i;
                            in[i] = (u32x4){0u, 0u, 0u, 0u};
                            if (gr >= seg_lo && gr < seg_hi) in[i] = *(const u32x4*)(XBC + (size_t)gr * 3072 + colbase); }
                        unsigned char* T = which == 0 ? Bs : Cs;
                        float wg[4];
#pragma unroll
                        for (int r = 0; r < 4; ++r) wg[r] = which == 0 ? __expf(total - cum[rg * 4 + r]) : 0.f;
                        u32 pk[4][4];
#pragma unroll
                        for (int c2 = 0; c2 < 4; ++c2) {
                            float olo[4], ohi[4];
                            { const int c = co * 8 + 2 * c2;
                              const float w0 = wb[c], w1 = wb[128 + c], w2 = wb[256 + c], w3 = wb[384 + c], w4 = wb[512 + c], bb = wb[640 + c];
#pragma unroll
                              for (int r = 0; r < 4; ++r) olo[r] = silu_f(bb + w0 * bflo(in[r][c2]) + w1 * bflo(in[r + 1][c2]) + w2 * bflo(in[r + 2][c2]) + w3 * bflo(in[r + 3][c2]) + w4 * bflo(in[r + 4][c2])); }
                            { const int c = co * 8 + 2 * c2 + 1;
                              const float w0 = wb[c], w1 = wb[128 + c], w2 = wb[256 + c], w3 = wb[384 + c], w4 = wb[512 + c], bb = wb[640 + c];
#pragma unroll
                              for (int r = 0; r < 4; ++r) ohi[r] = silu_f(bb + w0 * bfhi(in[r][c2]) + w1 * bfhi(in[r + 1][c2]) + w2 * bfhi(in[r + 2][c2]) + w3 * bfhi(in[r + 3][c2]) + w4 * bfhi(in[r + 4][c2])); }
#pragma unroll
                            for (int r = 0; r < 4; ++r) pk[r][c2] = pack2(olo[r], ohi[r]);
                            if (which == 0) {
                                u32x2 q0, q1;
                                q0[0] = pack2(olo[0] * wg[0], olo[1] * wg[1]); q0[1] = pack2(olo[2] * wg[2], olo[3] * wg[3]);
                                q1[0] = pack2(ohi[0] * wg[0], ohi[1] * wg[1]); q1[1] = pack2(ohi[2] * wg[2], ohi[3] * wg[3]);
                                *(u32x2*)(BTs + swz(co * 8 + 2 * c2, rg * 4)) = q0;
                                *(u32x2*)(BTs + swz(co * 8 + 2 * c2 + 1, rg * 4)) = q1;
                            }
                        }
#pragma unroll
                        for (int r = 0; r < 4; ++r) { u32x4 pv; pv[0] = pk[r][0]; pv[1] = pk[r][1]; pv[2] = pk[r][2]; pv[3] = pk[r][3];
                            *(u32x4*)(T + swz(rg * 4 + r, co * 8)) = pv; }
                    }
                    const int xo = tid & 3, l = tid >> 2;
                    u32x4 xin[5];
#pragma unroll
                    for (int k = 0; k < 5; ++k) { const int gr = row0 + l - 2 + k; xin[k] = (u32x4){0u, 0u, 0u, 0u};
                        if (gr >= seg_lo && gr < seg_hi) xin[k] = *(const u32x4*)(XBC + (size_t)gr * 3072 + xc0 + xo * 8); }
                    const float* wx = wts + 1536; const float dl = dtv[l];
#pragma unroll
                    for (int c2 = 0; c2 < 4; ++c2) {
                        { const int pc = xo * 8 + 2 * c2;
                          const float xv = silu_f(wx[160 + pc] + wx[pc] * bflo(xin[0][c2]) + wx[32 + pc] * bflo(xin[1][c2]) + wx[64 + pc] * bflo(xin[2][c2]) + wx[96 + pc] * bflo(xin[3][c2]) + wx[128 + pc] * bflo(xin[4][c2]));
                          *(u16*)(XTs + swz(pc, l)) = f2bf(xv * dl); }
                        { const int pc = xo * 8 + 2 * c2 + 1;
                          const float xv = silu_f(wx[160 + pc] + wx[pc] * bfhi(xin[0][c2]) + wx[32 + pc] * bfhi(xin[1][c2]) + wx[64 + pc] * bfhi(xin[2][c2]) + wx[96 + pc] * bfhi(xin[3][c2]) + wx[128 + pc] * bfhi(xin[4][c2]));
                          *(u16*)(XTs + swz(pc, l)) = f2bf(xv * dl); }
                    }
                }
                __syncthreads();
                bf16x8 afrag[4];
#pragma unroll
                for (int kk = 0; kk < 4; ++kk) afrag[kk] = *(const bf16x8*)(Cs + swz(wave * 16 + fr, kk * 32 + fq * 8));
#pragma unroll
                for (int st = 0; st < 8; ++st) {
                    const int s = st * 16 + fr;
                    const bool need = d == 0 ? (st <= wave) : (st >= wave);
                    if (need) {
                        f32x4 acc = (f32x4){0.f, 0.f, 0.f, 0.f};
#pragma unroll
                        for (int kk = 0; kk < 4; ++kk) { const bf16x8 bfrag = *(const bf16x8*)(Bs + swz(s, kk * 32 + fq * 8)); acc = __builtin_amdgcn_mfma_f32_16x16x32_bf16(afrag[kk], bfrag, acc, 0, 0, 0); }
                        const float cs = cum[s];
#pragma unroll
                        for (int jj = 0; jj < 4; ++jj) { const int l = wave * 16 + fq * 4 + jj; const bool valid = d == 0 ? (s <= l) : (s >= l);
                            const float val = valid ? acc[jj] * __expf(cum[l] - cs) : 0.f;
                            *(u16*)(Gs + swz(l, s)) = f2bf(val); }
                    } else {
#pragma unroll
                        for (int jj = 0; jj < 4; ++jj) *(u16*)(Gs + swz(wave * 16 + fq * 4 + jj, s)) = (u16)0;
                    }
                }
                __syncthreads();
                {
                    bf16x8 gfrag[4];
#pragma unroll
                    for (int kk = 0; kk < 4; ++kk) gfrag[kk] = *(const bf16x8*)(Gs + swz(wave * 16 + fr, kk * 32 + fq * 8));
#pragma unroll
                    for (int pt = 0; pt < 2; ++pt) {
                        f32x4 accD = (f32x4){0.f, 0.f, 0.f, 0.f}, accO = (f32x4){0.f, 0.f, 0.f, 0.f};
#pragma unroll
                        for (int kk = 0; kk < 4; ++kk) {
                            const bf16x8 xb = *(const bf16x8*)(XTs + swz(pt * 16 + fr, kk * 32 + fq * 8));
                            accD = __builtin_amdgcn_mfma_f32_16x16x32_bf16(gfrag[kk], xb, accD, 0, 0, 0);
                            const bf16x8 hb = *(const bf16x8*)(Hs + swz(pt * 16 + fr, kk * 32 + fq * 8));
                            accO = __builtin_amdgcn_mfma_f32_16x16x32_bf16(afrag[kk], hb, accO, 0, 0, 0);
                        }
                        const int pc = pt * 16 + fr;
#pragma unroll
                        for (int jj = 0; jj < 4; ++jj) { const int l = wave * 16 + fq * 4 + jj;
                            const float yv = accD[jj] + __expf(cum[l]) * accO[jj];
                            u16* yp = Y + (size_t)(row0 + l) * 2048 + xc0 + pc;
                            float outv;
                            if (d == 0) { const float xv = bf2f(*(const u16*)(XTs + swz(pc, l))) / dtv[l]; outv = Dh * xv + yv; }
                            else outv = bf2f(*yp) + yv;
                            *yp = f2bf(outv); }
                    }
                }
                {
                    const float et = __expf(total);
                    f32x4 nacc[2];
#pragma unroll
                    for (int pt = 0; pt < 2; ++pt) {
                        f32x4 acc = hreg[pt] * et;
#pragma unroll
                        for (int kk = 0; kk < 4; ++kk) {
                            const bf16x8 xa = *(const bf16x8*)(XTs + swz(pt * 16 + fr, kk * 32 + fq * 8));
                            const bf16x8 bb = *(const bf16x8*)(BTs + swz(wave * 16 + fr, kk * 32 + fq * 8));
                            acc = __builtin_amdgcn_mfma_f32_16x16x32_bf16(xa, bb, acc, 0, 0, 0);
                        }
                        nacc[pt] = acc; hreg[pt] = acc;
                    }
                    __syncthreads();
#pragma unroll
                    for (int pt = 0; pt < 2; ++pt)
#pragma unroll
                        for (int jj = 0; jj < 4; ++jj) *(u16*)(Hs + swz(pt * 16 + fq * 4 + jj, wave * 16 + fr)) = f2bf(nacc[pt][jj]);
                }
            }
        }
    }
}
__device__ void phase_ssd_gatenorm(const Params& p, int j) {
    const int lane = otid() & 63, gw = blockIdx.x * 8 + (otid() >> 6), nw = gridDim.x * 8;
    u16* Y = (u16*)(p.ws + OFF_Y); const u16* Z = (const u16*)(p.ws + OFF_Z); const float* ng = p.in[16] + (size_t)j * 2048;
    for (int row = gw; row < MT; row += nw) {
#pragma unroll
        for (int k = 0; k < 4; ++k) {
            const int c = k * 512 + lane * 8;
            const u32x4 yv = *(const u32x4*)(Y + (size_t)row * 2048 + c), zv = *(const u32x4*)(Z + (size_t)row * 2048 + c);
            float yf[8], zf[8], v[8]; unpack8(yv, yf); unpack8(zv, zf);
            float ss = 0.f;
#pragma unroll
            for (int i = 0; i < 8; ++i) { v[i] = yf[i] * silu_f(zf[i]); ss += v[i] * v[i]; }
            ss = wave_sum(ss);
            const float rstd = rsqrtf(ss * (1.f / 512.f) + 1e-6f);
            const float4 g0 = *(const float4*)(ng + c), g1 = *(const float4*)(ng + c + 4);
            u32x4 o;
            o[0] = pack2(v[0] * rstd * g0.x, v[1] * rstd * g0.y); o[1] = pack2(v[2] * rstd * g0.z, v[3] * rstd * g0.w);
            o[2] = pack2(v[4] * rstd * g1.x, v[5] * rstd * g1.y); o[3] = pack2(v[6] * rstd * g1.z, v[7] * rstd * g1.w);
            *(u32x4*)(Y + (size_t)row * 2048 + c) = o;
        }
    }
}

__device__ void phase_pool(const Params& p, unsigned char* lds) {
    float* cs = (float*)lds;
    const int tid = otid(), cp = tid & 127, cq = tid >> 7;
    const u16* U = (const u16*)(p.ws + OFF_U); u16* PO = (u16*)(p.ws + OFF_POOLED);
    for (int item = blockIdx.x; item < 2048 + 16; item += gridDim.x) {
        __syncthreads();
        if (item < 2048) {
            const int b = item >> 9, r = (item >> 2) & 127, g = item & 3, hw = 1 << g;
            const int rlo = max(r - hw, 0), rhi = min(r + hw, 128);
            const size_t base = (size_t)b * 8192;
#pragma unroll 4
            for (int ci = 0; ci < 16; ++ci) { const int c = cq + 4 * ci; float s0 = 0.f, s1 = 0.f;
                for (int rr = rlo; rr < rhi; ++rr) { const u32 v = *(const u32*)(U + (base + rr * 64 + c) * 1024 + g * 256 + 2 * cp); s0 += bflo(v); s1 += bfhi(v); }
                cs[c * 256 + 2 * cp] = s0; cs[c * 256 + 2 * cp + 1] = s1; }
            __syncthreads();
#pragma unroll 4
            for (int ci = 0; ci < 16; ++ci) { const int c = cq + 4 * ci; const int clo = max(c - hw, 0), chi = min(c + hw, 64);
                float s0 = 0.f, s1 = 0.f;
                for (int c2 = clo; c2 < chi; ++c2) { s0 += cs[c2 * 256 + 2 * cp]; s1 += cs[c2 * 256 + 2 * cp + 1]; }
                const float inv = 1.f / ((float)(rhi - rlo) * (float)(chi - clo));
                const size_t row = base + r * 64 + c;
                const u32 tk = *(const u32*)(U + row * 1024 + g * 256 + 2 * cp);
                *(u32*)(PO + row * 1024 + g * 256 + 2 * cp) = pack2(s0 * inv - bflo(tk), s1 * inv - bfhi(tk)); }
        } else {
            const int it = item - 2048, b = it >> 2, g = it & 3, hw = 1 << g;
            const size_t base = (size_t)ML + b * 256;
            for (int i = 0; i < 64; ++i) { const int t = cq + 4 * i; const int lo = max(t - hw, 0), hi = min(t + hw, 256);
                float s0 = 0.f, s1 = 0.f;
                for (int s = lo; s < hi; ++s) { const u32 v = *(const u32*)(U + (base + s) * 1024 + g * 256 + 2 * cp); s0 += bflo(v); s1 += bfhi(v); }
                const float inv = 1.f / (float)(hi - lo);
                const u32 tk = *(const u32*)(U + (base + t) * 1024 + g * 256 + 2 * cp);
                *(u32*)(PO + (base + t) * 1024 + g * 256 + 2 * cp) = pack2(s0 * inv - bflo(tk), s1 * inv - bfhi(tk)); }
        }
    }
}

__device__ __forceinline__ float2 cmul(float2 a, float2 b) { return make_float2(a.x * b.x - a.y * b.y, a.x * b.y + a.y * b.x); }
__device__ __forceinline__ float2 twid(float turns) { return make_float2(__builtin_amdgcn_cosf(turns), __builtin_amdgcn_sinf(turns)); }
__device__ void fft_fwd(float2* X) {
    const int tid = otid();
    for (int s = 8192; s >= 2; s >>= 2) {
        const int q = s >> 1, lq = __builtin_ctz(q); const float inv2s = 0.5f / (float)s, invs = 1.0f / (float)s;
#pragma unroll 2
        for (int it = 0; it < 8; ++it) {
            const int jx = tid + it * 512; const int grp = jx >> lq, pos = jx & (q - 1); const int i0 = grp * 2 * s + pos;
            const float2 a = X[i0], b = X[i0 + q], c = X[i0 + s], dd = X[i0 + s + q];
            float2 w1 = twid((float)pos * inv2s), w2 = twid((float)(pos + q) * inv2s), w3 = twid((float)pos * invs);
            w1.y = -w1.y; w2.y = -w2.y; w3.y = -w3.y;
            const float2 a1 = make_float2(a.x + c.x, a.y + c.y), c1 = cmul(make_float2(a.x - c.x, a.y - c.y), w1);
            const float2 b1 = make_float2(b.x + dd.x, b.y + dd.y), d1 = cmul(make_float2(b.x - dd.x, b.y - dd.y), w2);
            X[i0] = make_float2(a1.x + b1.x, a1.y + b1.y); X[i0 + q] = cmul(make_float2(a1.x - b1.x, a1.y - b1.y), w3);
            X[i0 + s] = make_float2(c1.x + d1.x, c1.y + d1.y); X[i0 + s + q] = cmul(make_float2(c1.x - d1.x, c1.y - d1.y), w3);
        }
        __syncthreads();
    }
}
__device__ void fft_inv(float2* X) {
    const int tid = otid();
    for (int s = 2; s <= 8192; s <<= 2) {
        const int q = s >> 1, lq = __builtin_ctz(q); const float inv2s = 0.5f / (float)s, invs = 1.0f / (float)s;
#pragma unroll 2
        for (int it = 0; it < 8; ++it) {
            const int jx = tid + it * 512; const int grp = jx >> lq, pos = jx & (q - 1); const int i0 = grp * 2 * s + pos;
            const float2 a = X[i0], b = X[i0 + q], c = X[i0 + s], dd = X[i0 + s + q];
            const float2 w3 = twid((float)pos * invs), w1 = twid((float)pos * inv2s), w2 = twid((float)(pos + q) * inv2s);
            const float2 bw = cmul(b, w3), dw = cmul(dd, w3);
            const float2 a1 = make_float2(a.x + bw.x, a.y + bw.y), b1 = make_float2(a.x - bw.x, a.y - bw.y);
            const float2 c1 = make_float2(c.x + dw.x, c.y + dw.y), d1 = make_float2(c.x - dw.x, c.y - dw.y);
            const float2 cw = cmul(c1, w1), dw2 = cmul(d1, w2);
            X[i0] = make_float2(a1.x + cw.x, a1.y + cw.y); X[i0 + s] = make_float2(a1.x - cw.x, a1.y - cw.y);
            X[i0 + q] = make_float2(b1.x + dw2.x, b1.y + dw2.y); X[i0 + s + q] = make_float2(b1.x - dw2.x, b1.y - dw2.y);
        }
        __syncthreads();
    }
}
__device__ __forceinline__ int brev14(int k) { return (int)(__brev((unsigned)k) >> 18); }
__device__ void spec_mul(float2* X, const float2* Ka, const float2* Kb) {
    for (int k = otid(); k <= 8192; k += 512) {
        const int pk = brev14(k), pm = brev14((16384 - k) & 16383);
        const float2 zk = X[pk], zm = X[pm];
        const float2 ua = make_float2(0.5f * (zk.x + zm.x), 0.5f * (zk.y - zm.y));
        const float2 ub = make_float2(0.5f * (zk.y + zm.y), -0.5f * (zk.x - zm.x));
        const float2 pa = cmul(ua, Ka[k]), pb = cmul(ub, Kb[k]);
        X[pk] = make_float2(pa.x - pb.y, pa.y + pb.x);
        X[pm] = make_float2(pa.x + pb.y, -pa.y + pb.x);
    }
    __syncthreads();
}
__device__ __forceinline__ float conv3_at(const u16* rowp, int n, int L, float w0, float w1, float w2, float bias) {
    const float c = bf2f(rowp[n]); const float l = n > 0 ? bf2f(rowp[n - 1]) : 0.f; const float r = n < L - 1 ? bf2f(rowp[n + 1]) : 0.f;
    return bias + w0 * l + w1 * c + w2 * r;
}
__device__ void phase_hyena_lat(const Params& p, unsigned char* lds) {
    float2* X = (float2*)lds; float* aux = (float*)(lds + 131072);
    float* w3s = aux; float* red = aux + 256;
    const int tid = otid(), lane = tid & 63, wave = tid >> 6;
    const u16* PT = (const u16*)(p.ws + OFF_PT); u16* YT = (u16*)(p.ws + OFF_YT);
    float2* KF = (float2*)(p.ws + OFF_KF) + (size_t)blockIdx.x * 4 * KF_STRIDE;
    float2* ZS = (float2*)(p.ws + OFF_ZS) + (size_t)blockIdx.x * 8192;
    const float* HID2 = (const float*)(p.ws + OFF_HID2); const float* fw3 = p.in[28];
    const float* cw = p.in[22]; const float* cb = p.in[23]; const float* hbias = p.in[30];
    for (int pair = blockIdx.x; pair < 512; pair += gridDim.x) {
        const int cha = 2 * pair;
        for (int o = 0; o < 2; ++o) {
            __syncthreads();
            if (tid < 256) { const int which = tid >> 6, jj = tid & 63; const int ch = cha + (which >> 1), dir = which & 1;
                w3s[tid] = fw3[(size_t)jj * 4096 + (o * 2 + dir) * 1024 + ch]; }
            __syncthreads();
            const float dela = 3.0701134573253945f + (float)cha * (12.280453829301578f / 1023.f);
            const float delb = 3.0701134573253945f + (float)(cha + 1) * (12.280453829301578f / 1023.f);
            float ssa = 0.f, ssb = 0.f;
            for (int i = 0; i < 16; ++i) {
                const int pos = tid + 512 * i;
                const float4* hr = (const float4*)(HID2 + (size_t)pos * 64);
                float d0 = 0.f, d1 = 0.f, d2 = 0.f, d3 = 0.f;
#pragma unroll
                for (int q4 = 0; q4 < 16; ++q4) { const float4 hv = hr[q4]; const int jb = q4 * 4;
                    d0 += hv.x * w3s[jb] + hv.y * w3s[jb + 1] + hv.z * w3s[jb + 2] + hv.w * w3s[jb + 3];
                    d1 += hv.x * w3s[64 + jb] + hv.y * w3s[64 + jb + 1] + hv.z * w3s[64 + jb + 2] + hv.w * w3s[64 + jb + 3];
                    d2 += hv.x * w3s[128 + jb] + hv.y * w3s[128 + jb + 1] + hv.z * w3s[128 + jb + 2] + hv.w * w3s[128 + jb + 3];
                    d3 += hv.x * w3s[192 + jb] + hv.y * w3s[192 + jb + 1] + hv.z * w3s[192 + jb + 2] + hv.w * w3s[192 + jb + 3]; }
                const float t = (float)pos / 8191.f; const float ea = __expf(-t * dela), eb = __expf(-t * delb);
                const float h0a = d0 * ea, h1a = d1 * ea, h0b = d2 * eb, h1b = d3 * eb;
                ssa += h0a * h0a + h1a * h1a; ssb += h0b * h0b + h1b * h1b;
                X[pos] = make_float2(h0a, h0b);
                if (pos >= 1) X[16384 - pos] = make_float2(h1a, h1b);
            }
            if (tid == 0) X[8192] = make_float2(0.f, 0.f);
            ssa = wave_sum(ssa); ssb = wave_sum(ssb);
            if (lane == 0) { red[wave] = ssa; red[8 + wave] = ssb; }
            __syncthreads();
            float ta = 0.f, tb = 0.f;
#pragma unroll
            for (int w = 0; w < 8; ++w) { ta += red[w]; tb += red[8 + w]; }
            const float sa = rsqrtf(ta + 1e-6f), sb = rsqrtf(tb + 1e-6f);
            fft_fwd(X);
            float2* Ka = KF + (size_t)(o * 2) * KF_STRIDE; float2* Kb = Ka + KF_STRIDE;
            for (int k = tid; k <= 8192; k += 512) {
                const int pk = brev14(k), pm = brev14((16384 - k) & 16383);
                const float2 zk = X[pk], zm = X[pm];
                Ka[k] = make_float2(sa * 0.5f * (zk.x + zm.x), sa * 0.5f * (zk.y - zm.y));
                Kb[k] = make_float2(sb * 0.5f * (zk.y + zm.y), -sb * 0.5f * (zk.x - zm.x));
            }
        }
        __threadfence_block();
        __syncthreads();
        float wv[2][3][4];
#pragma unroll
        for (int ab = 0; ab < 2; ++ab)
#pragma unroll
            for (int part = 0; part < 3; ++part) { const int cidx = part * 1024 + cha + ab;
                wv[ab][part][0] = cw[cidx]; wv[ab][part][1] = cw[3072 + cidx]; wv[ab][part][2] = cw[6144 + cidx]; wv[ab][part][3] = cb[cidx]; }
        const float hb0a = hbias[cha], hb0b = hbias[cha + 1], hb1a = hbias[1024 + cha], hb1b = hbias[1024 + cha + 1];
        for (int b = 0; b < 4; ++b) {
            const u16* va = PT + (size_t)cha * MT + (size_t)b * 8192; const u16* vb = va + MT;
            const u16* x1a = va + (size_t)1024 * MT; const u16* x1b = x1a + MT;
            const u16* x2a = va + (size_t)2048 * MT; const u16* x2b = x2a + MT;
            __syncthreads();
#pragma unroll 2
            for (int i = 0; i < 16; ++i) { const int n = tid + 512 * i;
                X[n] = make_float2(conv3_at(va, n, 8192, wv[0][0][0], wv[0][0][1], wv[0][0][2], wv[0][0][3]), conv3_at(vb, n, 8192, wv[1][0][0], wv[1][0][1], wv[1][0][2], wv[1][0][3]));
                X[n + 8192] = make_float2(0.f, 0.f); }
            __syncthreads();
            fft_fwd(X);
            spec_mul(X, KF, KF + KF_STRIDE);
            fft_inv(X);
#pragma unroll 2
            for (int i = 0; i < 16; ++i) { const int n = tid + 512 * i;
                const float2 c1 = X[n];
                const float v_a = conv3_at(va, n, 8192, wv[0][0][0], wv[0][0][1], wv[0][0][2], wv[0][0][3]), v_b = conv3_at(vb, n, 8192, wv[1][0][0], wv[1][0][1], wv[1][0][2], wv[1][0][3]);
                const float xa = conv3_at(x1a, n, 8192, wv[0][1][0], wv[0][1][1], wv[0][1][2], wv[0][1][3]), xb = conv3_at(x1b, n, 8192, wv[1][1][0], wv[1][1][1], wv[1][1][2], wv[1][1][3]);
                const float2 zv = make_float2(xa * (c1.x * (1.f / 16384.f) + v_a * hb0a), xb * (c1.y * (1.f / 16384.f) + v_b * hb0b));
                ZS[n] = zv; X[n] = zv; X[n + 8192] = make_float2(0.f, 0.f); }
            __syncthreads();
            fft_fwd(X);
            spec_mul(X, KF + 2 * KF_STRIDE, KF + 3 * KF_STRIDE);
            fft_inv(X);
#pragma unroll 2
            for (int i = 0; i < 16; ++i) { const int n = tid + 512 * i;
                const float2 c2 = X[n]; const float2 zv = ZS[n];
                const float xa = conv3_at(x2a, n, 8192, wv[0][2][0], wv[0][2][1], wv[0][2][2], wv[0][2][3]), xb = conv3_at(x2b, n, 8192, wv[1][2][0], wv[1][2][1], wv[1][2][2], wv[1][2][3]);
                YT[(size_t)cha * MT + (size_t)b * 8192 + n] = f2bf(xa * (c2.x * (1.f / 16384.f) + zv.x * hb1a));
                YT[(size_t)(cha + 1) * MT + (size_t)b * 8192 + n] = f2bf(xb * (c2.y * (1.f / 16384.f) + zv.y * hb1b)); }
        }
    }
}
__device__ void phase_hyena_ctx(const Params& p, unsigned char* lds) {
    float* kf = (float*)lds;
    float* vs = kf + 1024; float* x1s = vs + 1024; float* x2s = x1s + 1024; float* zs = x2s + 1024; float* red = zs + 1024;
    const int tid = otid(), lane = tid & 63, wave = tid >> 6;
    const u16* PT = (const u16*)(p.ws + OFF_PT); u16* YT = (u16*)(p.ws + OFF_YT);
    const float* HID2C = (const float*)(p.ws + OFF_HID2C); const float* fw3 = p.in[28];
    const float* cw = p.in[22]; const float* cb = p.in[23]; const float* hbias = p.in[30];
    for (int ch = blockIdx.x; ch < 1024; ch += gridDim.x) {
        __syncthreads();
        {
            const int pos = tid & 255, o = tid >> 8;
            const float* hr = HID2C + (size_t)pos * 64;
            float d0 = 0.f, d1 = 0.f;
            for (int jj = 0; jj < 64; ++jj) { const float hv = hr[jj]; d0 += hv * fw3[(size_t)jj * 4096 + (o * 2) * 1024 + ch]; d1 += hv * fw3[(size_t)jj * 4096 + (o * 2 + 1) * 1024 + ch]; }
            const float del = 3.0701134573253945f + (float)ch * (12.280453829301578f / 1023.f);
            const float e = __expf(-((float)pos / 255.f) * del);
            const float h0 = d0 * e, h1 = d1 * e;
            float ss = wave_sum(h0 * h0 + h1 * h1);
            if (lane == 0) red[wave] = ss;
            __syncthreads();
            const float tot = red[o * 4] + red[o * 4 + 1] + red[o * 4 + 2] + red[o * 4 + 3];
            const float sc = rsqrtf(tot + 1e-6f);
            kf[(o * 2) * 256 + pos] = h0 * sc; kf[(o * 2 + 1) * 256 + pos] = h1 * sc;
        }
        const float w00 = cw[ch], w01 = cw[3072 + ch], w02 = cw[6144 + ch], b0 = cb[ch];
        const float w10 = cw[1024 + ch], w11 = cw[3072 + 1024 + ch], w12 = cw[6144 + 1024 + ch], b1 = cb[1024 + ch];
        const float w20 = cw[2048 + ch], w21 = cw[3072 + 2048 + ch], w22 = cw[6144 + 2048 + ch], b2 = cb[2048 + ch];
        const float hb0 = hbias[ch], hb1 = hbias[1024 + ch];
#pragma unroll
        for (int r = 0; r < 2; ++r) { const int idx = tid + 512 * r, bb = idx >> 8, l = idx & 255;
            const u16* base = PT + (size_t)ch * MT + ML + bb * 256;
            vs[idx] = conv3_at(base, l, 256, w00, w01, w02, b0);
            x1s[idx] = conv3_at(base + (size_t)1024 * MT, l, 256, w10, w11, w12, b1);
            x2s[idx] = conv3_at(base + (size_t)2048 * MT, l, 256, w20, w21, w22, b2); }
        __syncthreads();
#pragma unroll
        for (int r = 0; r < 2; ++r) { const int idx = tid + 512 * r, bb = idx >> 8, l = idx & 255;
            float c = 0.f;
            for (int s = 0; s <= l; ++s) c += kf[l - s] * vs[bb * 256 + s];
            for (int s = l + 1; s < 256; ++s) c += kf[256 + s - l] * vs[bb * 256 + s];
            zs[idx] = x1s[idx] * (c + vs[idx] * hb0); }
        __syncthreads();
#pragma unroll
        for (int r = 0; r < 2; ++r) { const int idx = tid + 512 * r, bb = idx >> 8, l = idx & 255;
            float c = 0.f;
            for (int s = 0; s <= l; ++s) c += kf[512 + l - s] * zs[bb * 256 + s];
            for (int s = l + 1; s < 256; ++s) c += kf[768 + s - l] * zs[bb * 256 + s];
            YT[(size_t)ch * MT + ML + idx] = f2bf(x2s[idx] * (c + zs[idx] * hb1)); }
    }
}
__device__ void phase_transpose_y(const Params& p, unsigned char* lds) {
    u16* tile = (u16*)lds;
    const int tid = otid();
    const u16* YT = (const u16*)(p.ws + OFF_YT); u16* Yh = (u16*)(p.ws + OFF_U);
    for (int t = blockIdx.x; t < 16 * 528; t += gridDim.x) {
        const int c0 = (t / 528) << 6, r0 = (t % 528) << 6;
        __syncthreads();
#pragma unroll
        for (int r = 0; r < 4; ++r) { const int i = (tid >> 5) + 16 * r, j2 = (tid & 31) * 2;
            const u32 v = *(const u32*)(YT + (size_t)(c0 + i) * MT + r0 + j2); tile[i * 66 + j2] = (u16)(v & 0xFFFFu); tile[i * 66 + j2 + 1] = (u16)(v >> 16); }
        __syncthreads();
#pragma unroll
        for (int r = 0; r < 4; ++r) { const int jt = (tid >> 5) + 16 * r, c2 = (tid & 31) * 2;
            *(u32*)(Yh + (size_t)(r0 + jt) * 1024 + c0 + c2) = (u32)tile[c2 * 66 + jt] | ((u32)tile[(c2 + 1) * 66 + jt] << 16); }
    }
}

__global__ void __launch_bounds__(512, 2) hybrid_fwd(Params p) {
    extern __shared__ __attribute__((aligned(16))) unsigned char shm[];
    cg::grid_group grid = cg::this_grid();
    u16* U = (u16*)(p.ws + OFF_U);
    float* Hc = (float*)(p.ws + OFF_HC);
    phase_setup(p, shm);
    grid.sync();
    phase_modreduce(p);
    grid.sync();
#pragma unroll 1
    for (int layer = 0; layer < 4; ++layer) {
        const int kind = layer % 3, j = layer / 3;
        const float* modl = (const float*)(p.ws + OFF_MOD) + (size_t)layer * 5 * 9216;
#pragma unroll 1
        for (int sub = 0; sub < 3; ++sub) {
            if (sub == 0) convert_layer(p, layer, shm);
            phase_modulate(p, layer, sub);
            grid.sync();
            const u16* RA; const u16* RB; int RK; const float* rbias = (const float*)(p.ws + OFF_CONST); const float* rscale = rbias + 1024; float gmul;
            if (sub != 1) {
                const int f = sub == 0 ? 0 : 1;
                EpiFFN1 e1; e1.H = (u16*)(p.ws + OFF_HID);
                run_gemm(shm, U, (const u16*)(p.ws + (f ? OFF_WGU1 : OFF_WGU0)), MT, 5632, 1024, e1);
                grid.sync();
                RA = (const u16*)(p.ws + OFF_HID); RB = (const u16*)(p.ws + (f ? OFF_WD1 : OFF_WD0)); RK = FF; gmul = 0.5f;
            } else {
                gmul = 1.0f;
                if (kind == 0) {
                    EpiSSDin es; es.Z = (u16*)(p.ws + OFF_Z); es.XBC = (u16*)(p.ws + OFF_XBC); es.DT = (float*)(p.ws + OFF_DT);
                    run_gemm(shm, U, (const u16*)(p.ws + OFF_WM1), MT, 5376, 1024, es);
                    grid.sync();
                    phase_ssd_scan(p, j, shm);
                    grid.sync();
                    phase_ssd_gatenorm(p, j);
                    grid.sync();
                    RA = (const u16*)(p.ws + OFF_Y); RB = (const u16*)(p.ws + OFF_WM2); RK = 2048;
                } else if (kind == 1) {
                    phase_pool(p, shm);
                    grid.sync();
                    RA = (const u16*)(p.ws + OFF_POOLED); RB = (const u16*)(p.ws + OFF_WM1); RK = 1024; rbias = p.in[19]; rscale = p.in[20];
                } else {
                    EpiBf16T et; et.O = (u16*)(p.ws + OFF_PT); et.ldc = MT;
                    run_gemm(shm, (const u16*)(p.ws + OFF_WM1), U, 3072, MT, 1024, et);
                    grid.sync();
                    phase_hyena_lat(p, shm);
                    phase_hyena_ctx(p, shm);
                    grid.sync();
                    phase_transpose_y(p, shm);
                    grid.sync();
                    RA = U; RB = (const u16*)(p.ws + OFF_WM2); RK = 1024;
                }
            }
            const EpiResid er{p.out, Hc, modl + (3 * sub + 2) * 1024, rbias, rscale, gmul, 0.f};
            run_gemm(shm, RA, RB, MT, 1024, RK, er);
            grid.sync();
        }
    }
    phase_final(p);
}

extern "C" void kernel_launch(void* const* d_in, const int* in_sizes, int n_in, void* d_out, int out_size, void* d_ws, size_t ws_size, hipStream_t stream) {
    static int grid_blocks = 0;
    if (grid_blocks == 0) {
        if (n_in != 33 || out_size != ML * 1024 || ws_size < WS_END) { fprintf(stderr, "kernel_launch: unexpected problem (n_in %d, out %d, ws %zu < %zu)\n", n_in, out_size, ws_size, (size_t)WS_END); grid_blocks = -1; return; }
        int dev = 0, cus = 0, per_cu = 0;
        hipGetDevice(&dev);
        hipDeviceGetAttribute(&cus, hipDeviceAttributeMultiprocessorCount, dev);
        if (hipFuncSetAttribute((const void*)hybrid_fwd, hipFuncAttributeMaxDynamicSharedMemorySize, LDS_BYTES) != hipSuccess) { fprintf(stderr, "kernel_launch: hipFuncSetAttribute failed\n"); grid_blocks = -1; return; }
        hipOccupancyMaxActiveBlocksPerMultiprocessor(&per_cu, (const void*)hybrid_fwd, 512, LDS_BYTES);
        if (per_cu < 1) { fprintf(stderr, "kernel_launch: occupancy query says %d blocks per CU\n", per_cu); per_cu = 1; }
        (void)hipGetLastError();
        grid_blocks = cus * 1;
    }
    if (grid_blocks < 0) return;
    Params p{};
    for (int i = 0; i < 33; ++i) p.in[i] = (const float*)d_in[i];
    p.out = (float*)d_out; p.ws = (unsigned char*)d_ws;
    void* args[] = {&p};
    hipError_t e = hipLaunchCooperativeKernel((const void*)hybrid_fwd, dim3(grid_blocks), dim3(512), args, LDS_BYTES, stream);
    if (e != hipSuccess) fprintf(stderr, "cooperative launch failed: %s (grid %d)\n", hipGetErrorString(e), grid_blocks);
}
```

```cpp
#include <hip/hip_runtime.h>
#include <hip/hip_cooperative_groups.h>
#include <cstdio>
namespace cg = cooperative_groups;
__device__ __forceinline__ unsigned lane_id_now() { unsigned m = ~0u; asm volatile("" : "+v"(m)); return __builtin_amdgcn_mbcnt_hi(m, __builtin_amdgcn_mbcnt_lo(m, 0u)); }

#ifndef PROBE
#define PROBE 0
#endif
#ifndef PROBE_P1
#define PROBE_P1 7
#define PROBE_P2 27
#endif

#ifndef DBL_SCAN
#define DBL_SCAN 0
#endif
#ifndef DBL_HY
#define DBL_HY 0
#endif

namespace pg8 {
#define PG8_LAS __attribute__((address_space(3)))
typedef unsigned short bf16_t;
typedef short bf16x8 __attribute__((ext_vector_type(8)));
typedef float f32x4 __attribute__((ext_vector_type(4)));
typedef unsigned u32x4 __attribute__((ext_vector_type(4)));
constexpr int BM = 256, BK = 64, HALF = 128, HTB = HALF * BK * 2  , STAGE_BYTES = 8 * HTB, NXCD = 8, WGM = 8;

__host__ __device__ __forceinline__ int lds_byte(int r, int c) { const int st = (r >> 4) * 2 + (c >> 5), rr = r & 15, cc = c & 31, ob = rr * 64 + cc * 2; return st * 1024 + (ob ^ (((ob >> 9) & 1) << 5)); }
__host__ __device__ __forceinline__ void stage_rc(int b, int& R, int& C) { const int st = b / 1024, sb = b % 1024, swz = sb ^ (((sb >> 9) & 1) << 5); R = (st >> 1) * 16 + swz / 64; C = (st & 1) * 32 + (swz % 64) / 2; }
__host__ __device__ __forceinline__ int perm32(int rho) { const int n = rho >> 4, i = rho & 15; return 8 * (i >> 2) + 4 * n + (i & 3); }

struct Unit { int pm, pn; };
struct Gemm { const bf16_t* A; const bf16_t* Bt; int M, N, K, ld, wave; };
struct StaticOrder {
    int nM, nN, nwg, G, c;
    __host__ __device__ void init(int M, int N, int G_, int c_) { nM = M / BM; nN = N / BM; nwg = nM * nN; G = G_; c = c_; }
    __host__ __device__ bool next(int i, Unit& u) const {
        const long L = (long)i * G + c; if (L >= nwg) return false;
        int wgid = (int)L; { const int q = nwg / NXCD, r = nwg % NXCD, xcd = wgid % NXCD, off = wgid / NXCD; wgid = (xcd < r ? xcd * (q + 1) : r * (q + 1) + (xcd - r) * q) + off; }
        const int nig = WGM * nN, gid = wgid / nig, fm = gid * WGM, gsz = (nM - fm) < WGM ? (nM - fm) : WGM;
        u.pm = fm + ((wgid % nig) % gsz); u.pn = (wgid % nig) / gsz; return true;
    }
    __device__ __forceinline__ void a_ready(const Unit&) const {}
    __device__ __forceinline__ void done(const Unit&) const {}
};
__device__ __forceinline__ unsigned cvt_pk_bf16(float lo, float hi) { unsigned r; asm volatile("v_cvt_pk_bf16_f32 %0, %1, %2" : "=v"(r) : "v"(lo), "v"(hi)); return r; }
template <class Epi, class Sched>
__device__ __forceinline__ void gemm_phase(PG8_LAS unsigned char* lds, const Gemm g, const Sched S, const Epi E) {
    int tid_ = g.wave * 64 + (int)lane_id_now(); asm volatile("" : "+v"(tid_));
    const int tid = tid_, wid = __builtin_amdgcn_readfirstlane(tid >> 6), lane = tid & 63, wr = wid >> 2, wc = wid & 3, fr = lane & 15, fq = lane >> 4;
    const int K = g.K, nt = K / BK, LD = g.ld;
    unsigned voffA[2], voffB[2];
#pragma unroll
    for (int i = 0; i < 2; ++i) { int R, C; stage_rc(tid * 16 + i * 8192, R, C); const int Rb = Epi::PERM ? ((R & ~31) + perm32(R & 31)) : R;
        voffA[i] = (unsigned)(R * LD + C) * 2u; voffB[i] = (unsigned)(Rb * LD + C) * 2u; }
    const size_t kstep = (size_t)(BK * 2);
    const size_t hstep = (size_t)HALF * LD * 2;
    const size_t tstep = 2 * hstep;
    const unsigned ldsw = (unsigned)wid * 1024u;
    const int aoff = lds_byte(wr * 64 + fr, fq * 8), boff = lds_byte(wc * 32 + fr, fq * 8);
#define PG8_SA(b, h) (((b) * 2 + (h)) * HTB)
#define PG8_SB(b, h) ((4 + (b) * 2 + (h)) * HTB)
#define PG8_STAGE(bufoff, gbase, voff) do { _Pragma("unroll") for (int _i = 0; _i < 2; ++_i) \
        __builtin_amdgcn_global_load_lds((const unsigned*)((const char*)(gbase) + (voff)[_i]), (PG8_LAS unsigned*)(lds + (bufoff) + ldsw + _i * 8192), 16, 0, 0); } while (0)
#define PG8_LDA(dst, b, h) do { _Pragma("unroll") for (int m = 0; m < 4; ++m) _Pragma("unroll") for (int k = 0; k < 2; ++k) dst[m][k] = *(const PG8_LAS bf16x8*)(lds + PG8_SA(b, h) + aoff + m * 2048 + k * 1024); } while (0)
#define PG8_LDB(dst, b, h) do { _Pragma("unroll") for (int n = 0; n < 2; ++n) _Pragma("unroll") for (int k = 0; k < 2; ++k) dst[n][k] = *(const PG8_LAS bf16x8*)(lds + PG8_SB(b, h) + boff + n * 2048 + k * 1024); } while (0)
#define PG8_MMA(ai, bj, At, Bt) do { __builtin_amdgcn_s_setprio(1); _Pragma("unroll") for (int m = 0; m < 4; ++m) _Pragma("unroll") for (int n = 0; n < 2; ++n) _Pragma("unroll") for (int k = 0; k < 2; ++k) \
        acc[ai][bj][m][n] = __builtin_amdgcn_mfma_f32_16x16x32_bf16(Bt[n][k], At[m][k], acc[ai][bj][m][n], 0, 0, 0); __builtin_amdgcn_s_setprio(0); } while (0)
#define PG8_WAIT_V(n) asm volatile("s_waitcnt vmcnt(" #n ")" ::: "memory")
#define PG8_WAIT_L(n) asm volatile("s_waitcnt lgkmcnt(" #n ")" ::: "memory")
#define PG8_BAR __builtin_amdgcn_s_barrier()
#define PG8_SCHED __builtin_amdgcn_sched_barrier(0)
    Unit cur, nxt; int ui = 0;
    if (!S.next(0, cur)) return;
    f32x4 acc[2][2][4][2];
#pragma unroll
    for (int a = 0; a < 2; ++a)
#pragma unroll
        for (int b = 0; b < 2; ++b)
#pragma unroll
            for (int m = 0; m < 4; ++m)
#pragma unroll
                for (int n = 0; n < 2; ++n) acc[a][b][m][n] = (f32x4){0.f, 0.f, 0.f, 0.f};
    bf16x8 At[4][2], B0[2][2], B1[2][2];
    const char* cA = (const char*)g.A + (size_t)cur.pm * tstep; const char* cB = (const char*)g.Bt + (size_t)cur.pn * tstep;
    S.a_ready(cur);
    PG8_STAGE(PG8_SB(0, 0), cB, voffB); PG8_STAGE(PG8_SA(0, 0), cA, voffA); PG8_STAGE(PG8_SB(0, 1), cB + hstep, voffB); PG8_STAGE(PG8_SA(0, 1), cA + hstep, voffA);
    if (wr == 1) PG8_BAR;
    PG8_WAIT_V(4); PG8_BAR;
    PG8_STAGE(PG8_SB(1, 0), cB + kstep, voffB); PG8_STAGE(PG8_SA(1, 0), cA + kstep, voffA); PG8_STAGE(PG8_SB(1, 1), cB + hstep + kstep, voffB);
    PG8_WAIT_V(6); PG8_BAR;
    for (;;) {
        const bool has_next = S.next(ui + 1, nxt);
        const char* nA = has_next ? (const char*)g.A + (size_t)nxt.pm * tstep : cA; const char* nB = has_next ? (const char*)g.Bt + (size_t)nxt.pn * tstep : cB;
        for (int t = 0; t < nt; t += 2) {
            const bool last = (t == nt - 2);
            const char* a1 = cA + (size_t)(t + 1) * kstep;
            const char* a2 = last ? nA : cA + (size_t)(t + 2) * kstep; const char* b2 = last ? nB : cB + (size_t)(t + 2) * kstep;
            const char* a3 = a2 + kstep; const char* b3 = b2 + kstep;
            if (last && has_next) S.a_ready(nxt);
            PG8_LDB(B0, 0, 0); PG8_SCHED; PG8_LDA(At, 0, 0); PG8_STAGE(PG8_SA(1, 1), a1 + hstep, voffA);
            PG8_WAIT_L(8); PG8_BAR; PG8_WAIT_L(0); PG8_MMA(0, 0, At, B0); PG8_BAR; PG8_SCHED;
            PG8_LDB(B1, 0, 1); PG8_STAGE(PG8_SB(0, 0), b2, voffB);
            PG8_BAR; PG8_WAIT_L(0); PG8_MMA(0, 1, At, B1); PG8_BAR;
            PG8_LDA(At, 0, 1); PG8_STAGE(PG8_SA(0, 0), a2, voffA);
            PG8_BAR; PG8_WAIT_L(0); PG8_MMA(1, 0, At, B0); PG8_BAR; PG8_SCHED;
            PG8_STAGE(PG8_SB(0, 1), b2 + hstep, voffB);
            PG8_WAIT_V(6); PG8_BAR; PG8_MMA(1, 1, At, B1); PG8_BAR;
            PG8_LDB(B0, 1, 0); PG8_SCHED; PG8_LDA(At, 1, 0); PG8_STAGE(PG8_SA(0, 1), a2 + hstep, voffA);
            PG8_WAIT_L(8); PG8_BAR; PG8_WAIT_L(0); PG8_MMA(0, 0, At, B0); PG8_BAR; PG8_SCHED;
            PG8_LDB(B1, 1, 1); PG8_STAGE(PG8_SB(1, 0), b3, voffB);
            PG8_BAR; PG8_WAIT_L(0); PG8_MMA(0, 1, At, B1); PG8_BAR;
            PG8_LDA(At, 1, 1); PG8_STAGE(PG8_SA(1, 0), a3, voffA);
            PG8_BAR; PG8_WAIT_L(0); PG8_MMA(1, 0, At, B0); PG8_BAR; PG8_SCHED;
            PG8_STAGE(PG8_SB(1, 1), b3 + hstep, voffB);
            PG8_WAIT_V(6); PG8_BAR; PG8_MMA(1, 1, At, B1); PG8_BAR;
        }
        if constexpr (!Epi::AFTER_DRAIN) { E(acc, cur, wr, wc, fr, fq); S.done(cur); }
        if (!has_next) break;
#pragma unroll
        for (int a = 0; a < 2; ++a)
#pragma unroll
            for (int b = 0; b < 2; ++b)
#pragma unroll
                for (int m = 0; m < 4; ++m)
#pragma unroll
                    for (int n = 0; n < 2; ++n) acc[a][b][m][n] = (f32x4){0.f, 0.f, 0.f, 0.f};
        cur = nxt; cA = nA; cB = nB; ++ui;
    }
    PG8_WAIT_V(0);
    if (wr == 0) PG8_BAR;
    PG8_BAR;
    if constexpr (Epi::AFTER_DRAIN) { E.fused(acc, cur, wr, wc, fr, fq, lds, wid, lane); S.done(cur); }
#undef PG8_SA
#undef PG8_SB
#undef PG8_STAGE
#undef PG8_LDA
#undef PG8_LDB
#undef PG8_MMA
#undef PG8_WAIT_V
#undef PG8_WAIT_L
#undef PG8_BAR
#undef PG8_SCHED
}
}

using namespace pg8;
typedef unsigned short u16;
typedef unsigned u32;
typedef u32 u32x2 __attribute__((ext_vector_type(2)));
typedef float f32x2v __attribute__((ext_vector_type(2)));

constexpr int ML = 32768, MCX = 1024, MT = 33792, FF = 2816;
constexpr int LDS_BYTES = 159744;
constexpr size_t OFF_U = 0, SZ_U = (size_t)MT * 1024 * 2;
constexpr size_t OFF_BIG = OFF_U + SZ_U, SZ_BIG = (size_t)MT * 7168 * 2;
constexpr size_t SZ_WGU = (size_t)5632 * 1024 * 2, SZ_WD = (size_t)1024 * 2816 * 2;
constexpr size_t OFF_WGU0 = OFF_BIG + SZ_BIG, OFF_WD0 = OFF_WGU0 + SZ_WGU, OFF_WGU1 = OFF_WD0 + SZ_WD, OFF_WD1 = OFF_WGU1 + SZ_WGU;
constexpr size_t OFF_WM1 = OFF_WD1 + SZ_WD, SZ_WM1 = (size_t)5376 * 1024 * 2, OFF_WM2 = OFF_WM1 + SZ_WM1, SZ_WM2 = (size_t)2048 * 1024 * 2;
constexpr size_t OFF_MOD = OFF_WM2 + SZ_WM2, SZ_MOD = (size_t)4 * 5 * 9216 * 4;
constexpr size_t OFF_HC = OFF_MOD + SZ_MOD, SZ_HC = (size_t)1024 * 1024 * 4;
constexpr size_t OFF_DT = OFF_HC + SZ_HC, SZ_DT = (size_t)MT * 64 * 4;
constexpr size_t OFF_HID2 = OFF_DT + SZ_DT, SZ_HID2 = (size_t)8192 * 64 * 4;
constexpr size_t OFF_HID2C = OFF_HID2 + SZ_HID2, SZ_HID2C = (size_t)256 * 64 * 4;
constexpr size_t OFF_CONST = OFF_HID2C + SZ_HID2C;
constexpr size_t OFF_BAR = OFF_CONST + 8192;
constexpr size_t OFF_TS = OFF_BAR + 16384;
constexpr size_t OFF_TAB = OFF_TS + 1024;
constexpr size_t WS_END = OFF_TAB + 1024;
constexpr size_t OFF_HID = OFF_BIG;
constexpr size_t OFF_Z = OFF_BIG, OFF_XBC = OFF_BIG + (size_t)MT * 2048 * 2, OFF_Y = OFF_BIG + (size_t)MT * 5120 * 2;
constexpr size_t OFF_HALO = OFF_U, OFF_CUM = OFF_U + (size_t)8 * 1024 * 1024, OFF_CBG = OFF_U + (size_t)20 * 1024 * 1024, OFF_YC1 = OFF_U + (size_t)56 * 1024 * 1024;
constexpr size_t OFF_POOLED = OFF_BIG;
constexpr size_t OFF_PT = OFF_BIG, OFF_YT = OFF_BIG + (size_t)3072 * MT * 2, OFF_KF = OFF_BIG + (size_t)4096 * MT * 2;
constexpr size_t OFF_ZS = OFF_KF + (size_t)256 * 4 * 8200 * 8;
constexpr int KF_STRIDE = 8200;
constexpr size_t OFF_PART = OFF_BIG;
constexpr size_t OFF_CPART = OFF_BIG + (size_t)200 * 1024 * 1024;

__device__ __forceinline__ int otid_(int wave) { int t = wave * 64 + (int)lane_id_now(); asm volatile("" : "+v"(t)); return t; }
#define otid() otid_(p.wave)
#define LDS_BARRIER() asm volatile("s_waitcnt lgkmcnt(0)\n\ts_barrier" ::: "memory")
struct KArgs { const float* in[33]; float* out; unsigned char* ws; };
struct Params { const float* const* in; float* out; unsigned char* ws; int wave; };

__device__ __forceinline__ u16 f2bf(float f) { u32 u = __float_as_uint(f); u += 0x7FFFu + ((u >> 16) & 1u); return (u16)(u >> 16); }
__device__ __forceinline__ float bf2f(u16 b) { return __uint_as_float(((u32)b) << 16); }
__device__ __forceinline__ u32 pack2(float lo, float hi) { return (u32)f2bf(lo) | ((u32)f2bf(hi) << 16); }
__device__ __forceinline__ u32 pack2hw(float lo, float hi) { u32 r; asm("v_cvt_pk_bf16_f32 %0, %1, %2" : "=v"(r) : "v"(lo), "v"(hi)); return r; }
__device__ __forceinline__ float bflo(u32 v) { return __uint_as_float(v << 16); }
__device__ __forceinline__ float bfhi(u32 v) { return __uint_as_float(v & 0xFFFF0000u); }
__device__ __forceinline__ u32x4 zero4() { u32 z = 0u; asm volatile("" : "+v"(z)); u32x4 r; r[0] = z; r[1] = z; r[2] = z; r[3] = z; return r; }
__device__ __forceinline__ float4 zerof4() { float z = 0.f; asm volatile("" : "+v"(z)); return make_float4(z, z, z, z); }
__device__ __forceinline__ float silu_f(float x) { return x * __builtin_amdgcn_rcpf(1.f + __expf(-x)); }
__device__ __forceinline__ float wave_sum(float v) {
#pragma unroll
    for (int o = 32; o >= 1; o >>= 1) v += __shfl_xor(v, o);
    return v;
}

struct EpiFFN1 {
    static constexpr bool PERM = true, AFTER_DRAIN = false;
    u16* H;
    __device__ __forceinline__ void operator()(const f32x4 (&acc)[2][2][4][2], const Unit& u, int wr, int wc, int fr, int fq) const {
        const int row0 = u.pm * BM + wr * 64 + fr, col0 = u.pn * 128 + wc * 32 + 8 * fq;
#pragma unroll
        for (int ai = 0; ai < 2; ++ai)
#pragma unroll
            for (int m = 0; m < 4; ++m) {
                const f32x4 g0 = acc[ai][0][m][0], g1 = acc[ai][0][m][1], u0 = acc[ai][1][m][0], u1 = acc[ai][1][m][1];
                u32x4 o;
                o[0] = pack2hw(silu_f(g0[0]) * u0[0], silu_f(g0[1]) * u0[1]); o[1] = pack2hw(silu_f(g0[2]) * u0[2], silu_f(g0[3]) * u0[3]);
                o[2] = pack2hw(silu_f(g1[0]) * u1[0], silu_f(g1[1]) * u1[1]); o[3] = pack2hw(silu_f(g1[2]) * u1[2], silu_f(g1[3]) * u1[3]);
                *(u32x4*)(H + (size_t)(row0 + ai * HALF + m * 16) * FF + col0) = o;
            }
    }
};
struct EpiResid {
    static constexpr bool PERM = false, AFTER_DRAIN = false;
    float* X; const float* Xsrc; const float* gate0; const float* bias; const float* cscale; float gmul; float pad_;
    __device__ __forceinline__ void operator()(const f32x4 (&acc)[2][2][4][2], const Unit& u, int wr, int wc, int fr, int fq) const {
        const int b = u.pm >> 5;
        const float* gate = gate0 + b * 9216;
        const int row0 = u.pm * BM + wr * 64 + fr, col0 = u.pn * BM + wc * 32 + 4 * fq;
#pragma unroll
        for (int bj = 0; bj < 2; ++bj)
#pragma unroll
            for (int n = 0; n < 2; ++n) { const int c = col0 + bj * HALF + n * 16;
                const f32x4 gv = *(const f32x4*)(gate + c) * gmul;
                const f32x4 bv = *(const f32x4*)(bias + c);
                const f32x4 sv = *(const f32x4*)(cscale + c);
#pragma unroll
                for (int ai = 0; ai < 2; ++ai)
#pragma unroll
                    for (int m = 0; m < 4; ++m) { const size_t o = (size_t)(row0 + ai * HALF + m * 16) * 1024 + c;
                        const f32x4 v = (acc[ai][bj][m][n] + bv) * sv;
                        *(f32x4*)(X + o) = *(const f32x4*)(Xsrc + o) + gv * v; } }
    }
};
struct EpiResidPart {
    static constexpr bool PERM = false, AFTER_DRAIN = false;
    float* P; const float* gate0; const float* bias; const float* cscale; float gmul; float pad_;
    __device__ __forceinline__ void operator()(const f32x4 (&acc)[2][2][4][2], const Unit& u, int wr, int wc, int fr, int fq) const {
        const float* gate = gate0 + 4 * 9216;
        const int row0 = (u.pm - 128) * BM + wr * 64 + fr, col0 = u.pn * BM + wc * 32 + 4 * fq;
#pragma unroll
        for (int bj = 0; bj < 2; ++bj)
#pragma unroll
            for (int n = 0; n < 2; ++n) { const int c = col0 + bj * HALF + n * 16;
                const f32x4 gv = *(const f32x4*)(gate + c) * gmul;
                const f32x4 bv = *(const f32x4*)(bias + c);
                const f32x4 sv = *(const f32x4*)(cscale + c);
#pragma unroll
                for (int ai = 0; ai < 2; ++ai)
#pragma unroll
                    for (int m = 0; m < 4; ++m)
                        *(f32x4*)(P + (size_t)(row0 + ai * HALF + m * 16) * 1024 + c) = gv * ((acc[ai][bj][m][n] + bv) * sv); }
    }
};
struct OneUnit {
    Unit u; bool has;
    __device__ __forceinline__ bool next(int i, Unit& o) const { if (i == 0 && has) { o = u; return true; } return false; }
    __device__ __forceinline__ void a_ready(const Unit&) const {}
    __device__ __forceinline__ void done(const Unit&) const {}
};
struct EpiSSDin {
    static constexpr bool PERM = true, AFTER_DRAIN = false;
    u16* Z; u16* XBC; float* DT;
    __device__ __forceinline__ void operator()(const f32x4 (&acc)[2][2][4][2], const Unit& u, int wr, int wc, int fr, int fq) const {
        const int row0 = u.pm * BM + wr * 64 + fr, cw = wc * 32 + 8 * fq;
        if (u.pn < 20) {
            u16* base; int ld;
            if (u.pn < 8) { base = Z + u.pn * 256; ld = 2048; } else { base = XBC + (u.pn - 8) * 256; ld = 3072; }
#pragma unroll
            for (int ai = 0; ai < 2; ++ai)
#pragma unroll
                for (int m = 0; m < 4; ++m) { u16* rp = base + (size_t)(row0 + ai * HALF + m * 16) * ld + cw;
#pragma unroll
                    for (int bj = 0; bj < 2; ++bj) { const f32x4 v0 = acc[ai][bj][m][0], v1 = acc[ai][bj][m][1]; u32x4 o;
                        o[0] = pack2(v0[0], v0[1]); o[1] = pack2(v0[2], v0[3]); o[2] = pack2(v1[0], v1[1]); o[3] = pack2(v1[2], v1[3]);
                        *(u32x4*)(rp + bj * HALF) = o; } }
        } else if (wc < 2) {
#pragma unroll
            for (int ai = 0; ai < 2; ++ai)
#pragma unroll
                for (int m = 0; m < 4; ++m) { float* rp = DT + (size_t)(row0 + ai * HALF + m * 16) * 64 + cw;
                    *(f32x4*)(rp) = acc[ai][0][m][0]; *(f32x4*)(rp + 4) = acc[ai][0][m][1]; }
        }
    }
};
struct EpiBf16T {
    static constexpr bool PERM = true, AFTER_DRAIN = false;
    u16* O; int ldc;
    __device__ __forceinline__ void operator()(const f32x4 (&acc)[2][2][4][2], const Unit& u, int wr, int wc, int fr, int fq) const {
        const int row0 = u.pm * BM + wr * 64 + fr, col0 = u.pn * BM + wc * 32 + 8 * fq;
#pragma unroll
        for (int ai = 0; ai < 2; ++ai)
#pragma unroll
            for (int m = 0; m < 4; ++m) { u16* rp = O + (size_t)(row0 + ai * HALF + m * 16) * ldc + col0;
#pragma unroll
                for (int bj = 0; bj < 2; ++bj) { const f32x4 v0 = acc[ai][bj][m][0], v1 = acc[ai][bj][m][1]; u32x4 o;
                    o[0] = pack2(v0[0], v0[1]); o[1] = pack2(v0[2], v0[3]); o[2] = pack2(v1[0], v1[1]); o[3] = pack2(v1[2], v1[3]);
                    *(u32x4*)(rp + bj * HALF) = o; } }
    }
};
template <class Epi> __device__ __forceinline__ void run_gemm(int wave_, unsigned char* shm, const u16* A, const u16* Bt, int M, int N, int K, const Epi E) {
    StaticOrder S; S.init(M, N, (int)gridDim.x, (int)blockIdx.x);
    Gemm g; g.A = A; g.Bt = Bt; g.M = M; g.N = N; g.K = K; g.ld = K; g.wave = wave_;
    gemm_phase<Epi, StaticOrder>((PG8_LAS unsigned char*)shm, g, S, E);
}

__device__ __forceinline__ void phase_setup(const KArgs& p, unsigned char* shm, int wave_) {
    const int tid = otid_(wave_);
    if (blockIdx.x == 0 && tid < 33) ((const float**)(p.ws + OFF_TAB))[tid] = p.in[tid];
    float* fl = (float*)shm;
    if (blockIdx.x == 0) { float* cz = (float*)(p.ws + OFF_CONST); for (int i = tid; i < 2048; i += 512) cz[i] = i < 1024 ? 0.f : 1.f; }
    {
        const float* cvec = p.in[1]; const float* cctx = p.in[3]; const float* aw = p.in[4];
        float* part = (float*)(p.ws + OFF_PART);
        for (int it = blockIdx.x; it < 576; it += gridDim.x) {
            const int layer = it / 144, rem = it % 144, cc = rem >> 3, kc = rem & 7;
            __syncthreads();
            for (int i = tid; i < 640; i += 512) { const int r = i >> 7, k = i & 127; const float v = r < 4 ? cvec[r * 1024 + kc * 128 + k] : cctx[kc * 128 + k]; fl[i] = silu_f(v); }
            __syncthreads();
            const int col = cc * 512 + tid;
            float a0 = 0.f, a1 = 0.f, a2 = 0.f, a3 = 0.f, a4 = 0.f;
            const float* wp = aw + ((size_t)layer * 1024 + kc * 128) * 9216 + col;
#pragma unroll 8
            for (int k = 0; k < 128; ++k) { const float w = wp[(size_t)k * 9216]; a0 += fl[k] * w; a1 += fl[128 + k] * w; a2 += fl[256 + k] * w; a3 += fl[384 + k] * w; a4 += fl[512 + k] * w; }
            float* po = part + ((size_t)(kc * 4 + layer) * 5) * 9216 + col;
            po[0] = a0; po[9216] = a1; po[2 * 9216] = a2; po[3 * 9216] = a3; po[4 * 9216] = a4;
        }
    }
    {
        const float* fw1 = p.in[24]; const float* fb1 = p.in[25]; const float* fw2 = p.in[26]; const float* fb2 = p.in[27]; const float* fq = p.in[29];
        float* zs = fl + 1024; float* h1s = fl + 1024 + 8 * 36;
        const int pl = tid >> 6, jx = tid & 63;
        for (int grp = blockIdx.x; grp < 1056; grp += gridDim.x) {
            int L, pos; float* outp;
            if (grp < 1024) { L = 8192; pos = grp * 8 + pl; outp = (float*)(p.ws + OFF_HID2) + (size_t)pos * 64; }
            else { L = 256; pos = (grp - 1024) * 8 + pl; outp = (float*)(p.ws + OFF_HID2C) + (size_t)pos * 64; }
            __syncthreads();
            if (jx < 33) {
                float zv;
                if (jx == 0) zv = (float)pos / (float)(L - 1);
                else { const int k = (jx - 1) & 15; const float f = 1e-4f + (float)k * ((15.0f - 1e-4f) / 15.0f);
                    const float wpos = (6.283185307179586f * (float)pos) / (float)L; const float ang = wpos * f;
                    zv = jx <= 16 ? cosf(ang) : -sinf(ang); }
                zs[pl * 36 + jx] = zv;
            }
            __syncthreads();
            float a = fb1[jx];
            for (int i = 0; i < 33; ++i) a += zs[pl * 36 + i] * fw1[i * 64 + jx];
            h1s[pl * 64 + jx] = sinf(fq[jx] * a);
            __syncthreads();
            float a2 = fb2[jx];
            for (int i = 0; i < 64; ++i) a2 += h1s[pl * 64 + i] * fw2[i * 64 + jx];
            outp[jx] = sinf(fq[64 + jx] * a2);
        }
    }
}
__device__ __forceinline__ void phase_modreduce(const Params& p) {
    const float* part = (const float*)(p.ws + OFF_PART); const float* ab = p.in[5]; float* mod = (float*)(p.ws + OFF_MOD);
    for (int idx = blockIdx.x * 512 + otid(); idx < 4 * 5 * 9216; idx += gridDim.x * 512) {
        const int layer = idx / 46080, col = idx % 9216;
        float s = ab[layer * 9216 + col];
#pragma unroll
        for (int kc = 0; kc < 8; ++kc) s += part[(size_t)kc * 184320 + idx];
        mod[idx] = s;
    }
}

__device__ __forceinline__ void convert_job(const Params& p, const float* src, int K, int N, int lds_, u16* dst, int ldd, int nmul, int noff, int koff, unsigned char* shm) {
    float* tile = (float*)shm;
    const int tid = otid(), tk = K >> 6, tn = N >> 6, nt = tk * tn;
    float v[8], nv[8];
    int t = blockIdx.x;
    if (t < nt) { const int k0 = (t / tn) << 6, n0 = (t % tn) << 6;
#pragma unroll
        for (int r = 0; r < 8; ++r) v[r] = src[(size_t)(k0 + (tid >> 6) + 8 * r) * lds_ + n0 + (tid & 63)]; }
    for (; t < nt; t += gridDim.x) {
        const int k0 = (t / tn) << 6, n0 = (t % tn) << 6;
        const int t2 = t + (int)gridDim.x;
        if (t2 < nt) { const int k1 = (t2 / tn) << 6, n1 = (t2 % tn) << 6;
#pragma unroll
            for (int r = 0; r < 8; ++r) nv[r] = src[(size_t)(k1 + (tid >> 6) + 8 * r) * lds_ + n1 + (tid & 63)]; }
        LDS_BARRIER();
#pragma unroll
        for (int r = 0; r < 8; ++r) tile[((tid >> 6) + 8 * r) * 65 + (tid & 63)] = v[r];
        LDS_BARRIER();
#pragma unroll
        for (int r = 0; r < 4; ++r) { const int jn = (tid >> 5) + 16 * r, ik = (tid & 31) * 2; const int n = n0 + jn;
            const int nd = (n >> 7) * nmul + noff + (n & 127);
            *(u32*)(dst + (size_t)nd * ldd + koff + k0 + ik) = pack2(tile[ik * 65 + jn], tile[(ik + 1) * 65 + jn]); }
#pragma unroll
        for (int r = 0; r < 8; ++r) v[r] = nv[r];
    }
    __syncthreads();
}
__device__ __forceinline__ void convert_layer(const Params& p, int layer, unsigned char* shm) {
    const int kind = layer % 3, j = layer / 3;
    u16* wm1 = (u16*)(p.ws + OFF_WM1); u16* wm2 = (u16*)(p.ws + OFF_WM2);
    if (kind == 1) {
        for (int t = blockIdx.x; t < 192; t += gridDim.x) {
            const int ob = t >> 4, piece = t & 15; const int gr = ob / 3, gcr = ob % 3; const int gc = gcr + (gcr >= gr ? 1 : 0);
            const int tid = otid(); const int r = piece * 16 + (tid >> 5), c8 = (tid & 31) * 8;
            *(u32x4*)(wm1 + (size_t)(gr * 256 + r) * 1024 + gc * 256 + c8) = zero4();
        }
    }
    const int njobs = kind == 1 ? 10 : 8;
#pragma unroll 1
    for (int jb = 0; jb < njobs; ++jb) {
        const float* src; int K, N, ld, ldd, nmul = 128, noff = 0, koff = 0; u16* dst;
        if (jb < 6) { const int f = jb / 3, w = jb - 3 * f; const size_t wo = (size_t)(layer * 2 + f) * 1024 * FF;
            u16* wgu = (u16*)(p.ws + (f ? OFF_WGU1 : OFF_WGU0)); u16* wd = (u16*)(p.ws + (f ? OFF_WD1 : OFF_WD0));
            if (w < 2) { src = p.in[7 + w] + wo; K = 1024; N = FF; ld = FF; dst = wgu; ldd = 1024; nmul = 256; noff = w * 128; }
            else { src = p.in[9] + wo; K = FF; N = 1024; ld = 1024; dst = wd; ldd = FF; }
        } else if (kind == 0) {
            if (jb == 6) { src = p.in[10] + (size_t)j * 1024 * 5184; K = 1024; N = 5184; ld = 5184; dst = wm1; ldd = 1024; }
            else { src = p.in[17] + (size_t)j * 2048 * 1024; K = 2048; N = 1024; ld = 1024; dst = wm2; ldd = 2048; }
        } else if (kind == 1) { const int g = jb - 6;
            src = p.in[18] + (size_t)g * 65536; K = 256; N = 256; ld = 256; dst = wm1; ldd = 1024; noff = g * 256; koff = g * 256;
        } else {
            if (jb == 6) { src = p.in[21]; K = 1024; N = 3072; ld = 3072; dst = wm1; ldd = 1024; }
            else { src = p.in[31]; K = 1024; N = 1024; ld = 1024; dst = wm2; ldd = 1024; }
        }
        convert_job(p, src, K, N, ld, dst, ldd, nmul, noff, koff, shm);
    }
}

__device__ __forceinline__ void phase_modulate(const Params& p, int layer, int which, int nslice, bool first) {
    const int lane = otid() & 63, gw = blockIdx.x * 8 + (otid() >> 6), nw = gridDim.x * 8;
    const float* g = p.in[6] + (size_t)(layer * 3 + which) * 1024;
    const float* mod = (const float*)(p.ws + OFF_MOD) + (size_t)layer * 5 * 9216;
    const float* Hc = first ? p.in[2] : (const float*)(p.ws + OFF_HC); const float* Xl = first ? p.in[0] : (const float*)p.out; u16* U = (u16*)(p.ws + OFF_U);
    const int r0 = gw, r1 = MT;
    float4 A[4], H[4], v[4], nv[4]; int cb = -1;
    { const float* xr = r0 < ML ? Xl + (size_t)r0 * 1024 : Hc + (size_t)(r0 - ML) * 1024;
#pragma unroll
      for (int k = 0; k < 4; ++k) v[k] = *(const float4*)(xr + k * 256 + lane * 4); }
    for (int row = r0; row < r1; row += nw) {
        if (row + nw < r1) { const int rn = row + nw; const float* xr = rn < ML ? Xl + (size_t)rn * 1024 : Hc + (size_t)(rn - ML) * 1024;
#pragma unroll
            for (int k = 0; k < 4; ++k) nv[k] = *(const float4*)(xr + k * 256 + lane * 4); }
        const int b = row < ML ? (row >> 13) : 4;
        if (b != cb) { cb = b; const float* sh = mod + (size_t)b * 9216 + (3 * which) * 1024; const float* sc = sh + 1024;
#pragma unroll
            for (int k = 0; k < 4; ++k) { const int c = k * 256 + lane * 4; const float4 g4 = *(const float4*)(g + c), s4 = *(const float4*)(sc + c); H[k] = *(const float4*)(sh + c);
                A[k] = make_float4(g4.x * (1.f + s4.x), g4.y * (1.f + s4.y), g4.z * (1.f + s4.z), g4.w * (1.f + s4.w)); } }
        if (row >= ML && (nslice > 0 || first)) {
            const float* pp = (const float*)(p.ws + OFF_CPART) + (size_t)(row - ML) * 1024 + lane * 4;
            for (int sl = 0; sl < nslice; ++sl)
#pragma unroll
                for (int k = 0; k < 4; ++k) { const float4 q = *(const float4*)(pp + (size_t)sl * 1024 * 1024 + k * 256); v[k].x += q.x; v[k].y += q.y; v[k].z += q.z; v[k].w += q.w; }
            float* xw = (float*)(p.ws + OFF_HC) + (size_t)(row - ML) * 1024;
#pragma unroll
            for (int k = 0; k < 4; ++k) *(float4*)(xw + k * 256 + lane * 4) = v[k];
        }
        float ss = 0.f;
#pragma unroll
        for (int k = 0; k < 4; ++k) ss += v[k].x * v[k].x + v[k].y * v[k].y + v[k].z * v[k].z + v[k].w * v[k].w;
        ss = wave_sum(ss);
        const float rstd = rsqrtf(ss * (1.f / 1024.f) + 1e-6f);
#pragma unroll
        for (int k = 0; k < 4; ++k) { const int c = k * 256 + lane * 4;
            u32x2 o;
            o[0] = pack2(v[k].x * rstd * A[k].x + H[k].x, v[k].y * rstd * A[k].y + H[k].y);
            o[1] = pack2(v[k].z * rstd * A[k].z + H[k].z, v[k].w * rstd * A[k].w + H[k].w);
            *(u32x2*)(U + (size_t)row * 1024 + c) = o; }
#pragma unroll
        for (int k = 0; k < 4; ++k) v[k] = nv[k];
    }
}
__device__ __forceinline__ void phase_final(const Params& p) {
    const int lane = otid() & 63, gw = blockIdx.x * 8 + (otid() >> 6), nw = gridDim.x * 8;
    const float* g = p.in[32];
    for (int row = gw; row < ML; row += nw) {
        float* xr = p.out + (size_t)row * 1024;
        float4 v[4]; float ss = 0.f;
#pragma unroll
        for (int k = 0; k < 4; ++k) { v[k] = *(const float4*)(xr + k * 256 + lane * 4); ss += v[k].x * v[k].x + v[k].y * v[k].y + v[k].z * v[k].z + v[k].w * v[k].w; }
        ss = wave_sum(ss);
        const float rstd = rsqrtf(ss * (1.f / 1024.f) + 1e-6f);
#pragma unroll
        for (int k = 0; k < 4; ++k) { const int c = k * 256 + lane * 4; const float4 g4 = *(const float4*)(g + c);
            float4 o; o.x = v[k].x * rstd * g4.x; o.y = v[k].y * rstd * g4.y; o.z = v[k].z * rstd * g4.z; o.w = v[k].w * rstd * g4.w;
            *(float4*)(xr + c) = o; }
    }
}

#define XB_TMO      128
#define XB_XCNT(j)  (256  + 64 * (j))
#define XB_XSUB(j)  (1280 + 64 * (j))
#define XB_XGEN(j)  (2304 + 64 * (j))
#define XB_TOP      3328
#define XB_TOPGEN   3392
#define XCD_BAR_WORDS 3456
#define XB_SPIN_CAP (1u << 18)

__device__ __forceinline__ unsigned xb_ld(unsigned* p)              { return __hip_atomic_load(p, __ATOMIC_RELAXED, __HIP_MEMORY_SCOPE_AGENT); }
__device__ __forceinline__ unsigned xb_add(unsigned* p, unsigned v) { return __hip_atomic_fetch_add(p, v, __ATOMIC_RELAXED, __HIP_MEMORY_SCOPE_AGENT); }
__device__ __forceinline__ unsigned xb_xcc_id() { return (unsigned)__builtin_amdgcn_s_getreg((3 << 11) | 20) & 0xFu; }
#define XB_SPIN(cond, bar) do { unsigned _sp = 0; while (cond) { __builtin_amdgcn_s_sleep(1); \
    if ((++_sp & 255u) == 0u) { if (xb_ld(&(bar)[XB_TMO])) break; if (_sp > XB_SPIN_CAP) { atomicAdd(&(bar)[XB_TMO], 1u); break; } } } } while (0)

struct XcdBarrier {
    unsigned* bar; unsigned x; int wave;
    volatile PG8_LAS unsigned* st;
};

__device__ __forceinline__ XcdBarrier xcd_barrier_post(unsigned* bar, volatile PG8_LAS unsigned* st) {
    XcdBarrier b; b.bar = bar; b.x = xb_xcc_id(); b.st = st;
    if (threadIdx.x == 0) (void)xb_add(&bar[XB_XCNT(b.x)], 1u);
    return b;
}
__device__ __forceinline__ void xcd_barrier_complete(unsigned* bar, unsigned x, unsigned& nloc, unsigned& nx) {
    const unsigned G = gridDim.x * gridDim.y * gridDim.z;
    unsigned sum, cnt, mine, sp = 0u;
    for (;;) {
        sum = 0u; cnt = 0u; mine = 0u;
#pragma unroll
        for (unsigned j = 0; j < 16; ++j) { const unsigned c = xb_ld(&bar[XB_XCNT(j)]); sum += c; cnt += (c > 0u) ? 1u : 0u; mine = (j == x) ? c : mine; }
        if (sum == G) break;
        __builtin_amdgcn_s_sleep(1);
        if ((++sp & 255u) == 0u) { if (xb_ld(&bar[XB_TMO])) break; if (sp > XB_SPIN_CAP) { atomicAdd(&bar[XB_TMO], 1u); break; } }
    }
    nloc = mine > 0u ? mine : 1u; nx = cnt > 0u ? cnt : 1u;
}

__device__ __forceinline__ void xcd_barrier(const XcdBarrier& b) {
    asm volatile("s_waitcnt vmcnt(0)" ::: "memory");
    __syncthreads();
    if (b.wave == 0 && lane_id_now() == 0u) {
        unsigned* bar = b.bar;
        __builtin_amdgcn_s_waitcnt(0);
        unsigned nloc = b.st[0], nx = b.st[1];
        if (nloc == 0u) { xcd_barrier_complete(bar, b.x, nloc, nx); b.st[0] = nloc; b.st[1] = nx; }
        const unsigned old = xb_add(&bar[XB_XSUB(b.x)], 1u);
        const unsigned gen = old / nloc;
        if (old + 1u == (gen + 1u) * nloc) {
            __builtin_amdgcn_fence(__ATOMIC_RELEASE, "agent");
            asm volatile("s_waitcnt vmcnt(0)" ::: "memory");
            const unsigned og = xb_add(&bar[XB_TOP], 1u);
            const unsigned tg = og / nx;
            if (og + 1u == (tg + 1u) * nx) xb_add(&bar[XB_TOPGEN], 1u);
            else XB_SPIN(xb_ld(&bar[XB_TOPGEN]) == tg, bar);
            __builtin_amdgcn_fence(__ATOMIC_ACQUIRE, "agent");
            xb_add(&bar[XB_XGEN(b.x)], 1u);
            asm volatile("s_waitcnt vmcnt(0)" ::: "memory");
        } else {
            XB_SPIN(xb_ld(&bar[XB_XGEN(b.x)]) == gen, bar);
            __builtin_amdgcn_fence(__ATOMIC_ACQUIRE, "agent");
            asm volatile("s_waitcnt vmcnt(0)" ::: "memory");
        }
    }
    __syncthreads();
}


__device__ __forceinline__ int swz(int row, int col) { return row * 256 + ((((col >> 3) ^ (row & 15))) << 4) + ((col & 7) << 1); }
__device__ __forceinline__ void unpack8(const u32x4 v, float (&f)[8]) {
    f[0] = bflo(v[0]); f[1] = bfhi(v[0]); f[2] = bflo(v[1]); f[3] = bfhi(v[1]); f[4] = bflo(v[2]); f[5] = bfhi(v[2]); f[6] = bflo(v[3]); f[7] = bfhi(v[3]);
}
__device__ __forceinline__ void phase_ssd_prep1(const Params& p, int j) {
    const int tid = otid();
    const u16* XBC = (const u16*)(p.ws + OFF_XBC); u16* HALO = (u16*)(p.ws + OFF_HALO);
    for (int idx = blockIdx.x * 512 + tid; idx < 264 * 4 * 384; idx += gridDim.x * 512) {
        const int q = idx / 1536, rem = idx - q * 1536, hr = rem / 384, v = rem - hr * 384;
        const int row = q * 128 + (hr < 2 ? hr - 2 : 126 + hr);
        int seg_lo, seg_hi;
        if (q < 256) { seg_lo = (q >> 6) * 8192; seg_hi = seg_lo + 8192; } else { seg_lo = ML + ((q - 256) >> 1) * 256; seg_hi = seg_lo + 256; }
        u32x4 val = zero4();
        if (row >= seg_lo && row < seg_hi) val = *(const u32x4*)(XBC + (size_t)row * 3072 + v * 8);
        *(u32x4*)(HALO + (size_t)(q * 4 + hr) * 3072 + v * 8) = val;
    }
    float* DT = (float*)(p.ws + OFF_DT); float* CUM = (float*)(p.ws + OFF_CUM);
    for (int gid = blockIdx.x * 512 + tid; gid < 264 * 64; gid += gridDim.x * 512) {
        const int q = gid >> 6, col = gid & 63, d = col >> 5;
        const float Aneg = -__expf(p.in[13][j * 64 + col]), dtb = p.in[14][j * 64 + col];
        float s = 0.f;
#pragma unroll 1
        for (int i0 = 0; i0 < 128; i0 += 16) {
            float raw[16];
#pragma unroll
            for (int k = 0; k < 16; ++k) { const int l = d == 0 ? i0 + k : 127 - i0 - k; raw[k] = DT[(size_t)(q * 128 + l) * 64 + col]; }
#pragma unroll
            for (int k = 0; k < 16; ++k) { const int l = d == 0 ? i0 + k : 127 - i0 - k; const size_t o = (size_t)(q * 128 + l) * 64 + col;
                const float r = raw[k] + dtb; const float dt = r > 20.f ? r : log1pf(__expf(r));
                s += dt * Aneg; DT[o] = dt; CUM[(size_t)(q * 64 + col) * 128 + l] = s; }
        }
    }
}
__device__ __forceinline__ void phase_ssd_prep2(const Params& p, int j) {
    const int tid = otid(), co = tid & 31, rg = tid >> 5;
    u16* XBC = (u16*)(p.ws + OFF_XBC); const u16* HALO = (const u16*)(p.ws + OFF_HALO);
    const float* conv_w = p.in[11] + (size_t)j * 5 * 3072; const float* conv_b = p.in[12] + (size_t)j * 3072;
#define PREP2_LOAD(dst, it_) do { const int q_ = (it_) / 12, cs_ = (it_) - q_ * 12; const int col_ = cs_ * 256 + co * 8; \
        _Pragma("unroll") for (int i = 0; i < 12; ++i) { const int l = rg * 8 - 2 + i;     \
            const u16* src = l < 0 ? HALO + (size_t)(q_ * 4 + 2 + l) * 3072 : (l >= 128 ? HALO + (size_t)(q_ * 4 + l - 126) * 3072 : XBC + (size_t)(q_ * 128 + l) * 3072); \
            dst[i] = *(const u32x4*)(src + col_); } } while (0)
    u32x4 in[12], nin[12];
    if ((int)blockIdx.x < 264 * 12) PREP2_LOAD(in, (int)blockIdx.x);
    for (int item = blockIdx.x; item < 264 * 12; item += gridDim.x) {
        const int q = item / 12, cs = item - q * 12; const int col = cs * 256 + co * 8;
        asm volatile("s_waitcnt vmcnt(0)" ::: "memory");
        __syncthreads();
        if (item + (int)gridDim.x < 264 * 12) PREP2_LOAD(nin, item + (int)gridDim.x);
        u32 pk[8][4];
#pragma unroll
        for (int c2 = 0; c2 < 4; ++c2) {
            { const int c = col + 2 * c2; const float w0 = conv_w[c], w1 = conv_w[3072 + c], w2 = conv_w[6144 + c], w3 = conv_w[9216 + c], w4 = conv_w[12288 + c], bb = conv_b[c];
#pragma unroll
              for (int r = 0; r < 8; ++r) pk[r][c2] = (u32)f2bf(silu_f(bb + w0 * bflo(in[r][c2]) + w1 * bflo(in[r + 1][c2]) + w2 * bflo(in[r + 2][c2]) + w3 * bflo(in[r + 3][c2]) + w4 * bflo(in[r + 4][c2]))); }
            { const int c = col + 2 * c2 + 1; const float w0 = conv_w[c], w1 = conv_w[3072 + c], w2 = conv_w[6144 + c], w3 = conv_w[9216 + c], w4 = conv_w[12288 + c], bb = conv_b[c];
#pragma unroll
              for (int r = 0; r < 8; ++r) pk[r][c2] |= (u32)f2bf(silu_f(bb + w0 * bfhi(in[r][c2]) + w1 * bfhi(in[r + 1][c2]) + w2 * bfhi(in[r + 2][c2]) + w3 * bfhi(in[r + 3][c2]) + w4 * bfhi(in[r + 4][c2]))) << 16; }
        }
#pragma unroll
        for (int r = 0; r < 8; ++r) { u32x4 pv; pv[0] = pk[r][0]; pv[1] = pk[r][1]; pv[2] = pk[r][2]; pv[3] = pk[r][3];
            *(u32x4*)(XBC + (size_t)(q * 128 + rg * 8 + r) * 3072 + col) = pv; }
#pragma unroll
        for (int i = 0; i < 12; ++i) in[i] = nin[i];
    }
#undef PREP2_LOAD
}
__device__ __forceinline__ void phase_ssd_cb(const Params& p, unsigned char* lds) {
    const int tid = otid(), wave = __builtin_amdgcn_readfirstlane(tid >> 6), lane = tid & 63, fr = lane & 15, fq = lane >> 4;
    unsigned char* Cs = lds; unsigned char* Bs = lds + 32768;
    const u16* XBC = (const u16*)(p.ws + OFF_XBC); u16* CBG = (u16*)(p.ws + OFF_CBG);
    const int co = tid & 15, rg = tid >> 4;
    for (int item = blockIdx.x; item < 264 * 4; item += gridDim.x) {
        const int q = item >> 2, g = item & 3;
        u32x4 cv[4], bv[4];
#pragma unroll
        for (int r = 0; r < 4; ++r) { const size_t ro = (size_t)(q * 128 + rg * 4 + r) * 3072;
            cv[r] = *(const u32x4*)(XBC + ro + 2560 + g * 128 + co * 8); bv[r] = *(const u32x4*)(XBC + ro + 2048 + g * 128 + co * 8); }
        __syncthreads();
#pragma unroll
        for (int r = 0; r < 4; ++r) { *(u32x4*)(Cs + swz(rg * 4 + r, co * 8)) = cv[r]; *(u32x4*)(Bs + swz(rg * 4 + r, co * 8)) = bv[r]; }
        __syncthreads();
        bf16x8 afrag[4];
#pragma unroll
        for (int kk = 0; kk < 4; ++kk) afrag[kk] = *(const bf16x8*)(Cs + swz(wave * 16 + fr, kk * 32 + fq * 8));
#pragma unroll
        for (int st = 0; st < 8; ++st) {
            f32x4 acc = (f32x4){0.f, 0.f, 0.f, 0.f};
#pragma unroll
            for (int kk = 0; kk < 4; ++kk) { const bf16x8 bfrag = *(const bf16x8*)(Bs + swz(st * 16 + fr, kk * 32 + fq * 8)); acc = __builtin_amdgcn_mfma_f32_16x16x32_bf16(bfrag, afrag[kk], acc, 0, 0, 0); }
            u32x2 o; o[0] = pack2(acc[0], acc[1]); o[1] = pack2(acc[2], acc[3]);
            *(u32x2*)(CBG + (size_t)item * 16384 + (wave * 16 + fr) * 128 + st * 16 + fq * 4) = o;
        }
    }
}
__device__ __forceinline__ void phase_ssd_scan(const Params& p, int j, unsigned char* lds) {
    const int tid0 = otid(), wave = __builtin_amdgcn_readfirstlane(tid0 >> 6);
    unsigned char* Cs = lds; unsigned char* BTs = lds + 32768; unsigned char* Gs = lds + 65536;
    unsigned char* XTs = lds + 98304; unsigned char* Hs = lds + 114688;
    float* cum = (float*)(lds + 131072); float* dtv = cum + 128;
    const u16* XBC = (const u16*)(p.ws + OFF_XBC); const float* DT = (const float*)(p.ws + OFF_DT); const float* CUM = (const float*)(p.ws + OFF_CUM);
    const u16* CBG = (const u16*)(p.ws + OFF_CBG); u16* Y = (u16*)(p.ws + OFF_Y); u16* YC1 = (u16*)(p.ws + OFF_YC1);
    {
        const int it0 = (int)blockIdx.x;
        const int gid = (it0 & 7) + 8 * (it0 >> 6), member = (it0 >> 3) & 7;
        const int d = gid & 1, b = gid >> 3, g = (gid >> 1) & 3, h = g * 8 + member;
        const int xc0 = h * 64, bc0 = 2048 + g * 128, cc0 = 2560 + g * 128, col = d * 32 + h;
        const float Dh = p.in[15][j * 32 + h];
        f32x4 hreg[4];
#pragma unroll
        for (int pt = 0; pt < 4; ++pt) hreg[pt] = (f32x4){0.f, 0.f, 0.f, 0.f};
        __syncthreads();
        *(u32x4*)(Hs + tid0 * 32) = zero4(); *(u32x4*)(Hs + tid0 * 32 + 16) = zero4();
        u32x4 Cr[4], Br[4], Gr[4], Xr[2]; f32x4 cumr, cums0, cums1; float dtl[2], cum128 = 0.f, dt128 = 0.f, tot; u32x2 yold[4];
#define SSD_ROW0(ci) ((ci) < 2 ? ML + b * 256 + (d == 0 ? (ci) : 1 - (ci)) * 128 : b * 8192 + (d == 0 ? (ci) - 2 : 65 - (ci)) * 128)
#define SSD_LOAD(ci, T) do { const int r0_ = SSD_ROW0(ci); const int co_ = (T) & 15, rg_ = (T) >> 4, xo_ = (T) & 7, l_ = (T) >> 3; \
            const float* cb_ = CUM + (size_t)((r0_ >> 7) * 64 + col) * 128; const u16* gb_ = CBG + (size_t)((r0_ >> 7) * 4 + g) * 16384; \
            _Pragma("unroll") for (int r = 0; r < 4; ++r) { const size_t ro_ = (size_t)(r0_ + rg_ * 4 + r); \
                Cr[r] = *(const u32x4*)(XBC + ro_ * 3072 + cc0 + co_ * 8); Br[r] = *(const u32x4*)(XBC + ro_ * 3072 + bc0 + co_ * 8); \
                Gr[r] = *(const u32x4*)(gb_ + (rg_ * 4 + r) * 128 + co_ * 8); } \
            cumr = *(const f32x4*)(cb_ + rg_ * 4); cums0 = *(const f32x4*)(cb_ + co_ * 8); cums1 = *(const f32x4*)(cb_ + co_ * 8 + 4); \
            _Pragma("unroll") for (int i = 0; i < 2; ++i) { Xr[i] = *(const u32x4*)(XBC + (size_t)(r0_ + l_ + 64 * i) * 3072 + xc0 + xo_ * 8); dtl[i] = DT[(size_t)(r0_ + l_ + 64 * i) * 64 + col]; } \
            tot = cb_[d == 0 ? 127 : 0]; \
            if ((T) < 128) { cum128 = cb_[(T)]; dt128 = DT[(size_t)(r0_ + (T)) * 64 + col]; } \
            } while (0)
#define SSD_LOADY(ci, T) do { if ((ci) >= 34) { const int r0_ = SSD_ROW0(ci); const int fr_ = (T) & 15, fq_ = ((T) & 63) >> 4; \
                _Pragma("unroll") for (int pt = 0; pt < 4; ++pt) yold[pt] = *(const u32x2*)(Y + (size_t)(r0_ + wave * 16 + fr_) * 2048 + xc0 + pt * 16 + fq_ * 4); } } while (0)
        SSD_LOAD(0, tid0);
        for (int ci = 0; ci < 66; ++ci) {
            int tid = tid0; asm volatile("" : "+v"(tid));
            if (ci == 34) {
                XcdBarrier xb_; xb_.bar = (unsigned*)(p.ws + OFF_BAR); xb_.x = xb_xcc_id(); xb_.wave = p.wave; xb_.st = (volatile PG8_LAS unsigned*)((PG8_LAS unsigned char*)lds + (LDS_BYTES - 16));
                xcd_barrier(xb_);
                SSD_LOAD(34, tid); SSD_LOADY(34, tid);
            }
            const int lane = tid & 63, fr = lane & 15, fq = lane >> 4;
            const int row0 = SSD_ROW0(ci);
            const float total = tot;
            {
                const int co = tid & 15, rg = tid >> 4;
                float wg[4];
#pragma unroll
                for (int r = 0; r < 4; ++r) { *(u32x4*)(Cs + swz(rg * 4 + r, co * 8)) = Cr[r]; wg[r] = __expf(total - cumr[r]); }
#pragma unroll
                for (int c2 = 0; c2 < 4; ++c2) { u32x2 q0, q1;
                    q0[0] = pack2hw(bflo(Br[0][c2]) * wg[0], bflo(Br[1][c2]) * wg[1]); q0[1] = pack2hw(bflo(Br[2][c2]) * wg[2], bflo(Br[3][c2]) * wg[3]);
                    q1[0] = pack2hw(bfhi(Br[0][c2]) * wg[0], bfhi(Br[1][c2]) * wg[1]); q1[1] = pack2hw(bfhi(Br[2][c2]) * wg[2], bfhi(Br[3][c2]) * wg[3]);
                    *(u32x2*)(BTs + swz(co * 8 + 2 * c2, rg * 4)) = q0; *(u32x2*)(BTs + swz(co * 8 + 2 * c2 + 1, rg * 4)) = q1; }
#pragma unroll
                for (int r = 0; r < 4; ++r) { const int l = rg * 4 + r; const float cl = cumr[r]; u32x4 gv;
#pragma unroll
                    for (int c2 = 0; c2 < 4; ++c2) { const int s0 = co * 8 + 2 * c2;
                        const float cs0 = c2 < 2 ? cums0[2 * c2] : cums1[2 * c2 - 4], cs1 = c2 < 2 ? cums0[2 * c2 + 1] : cums1[2 * c2 - 3];
                        const bool v0 = d == 0 ? (s0 <= l) : (s0 >= l), v1 = d == 0 ? (s0 + 1 <= l) : (s0 + 1 >= l);
                        const float g0 = v0 ? bflo(Gr[r][c2]) * __expf(cl - cs0) : 0.f, g1 = v1 ? bfhi(Gr[r][c2]) * __expf(cl - cs1) : 0.f;
                        gv[c2] = pack2hw(g0, g1); }
                    *(u32x4*)(Gs + swz(l, co * 8)) = gv; }
                const int xo = tid & 7;
#pragma unroll
                for (int i = 0; i < 2; ++i) { const int l = (tid >> 3) + 64 * i;
#pragma unroll
                    for (int c2 = 0; c2 < 4; ++c2) { const u32 pr = pack2hw(bflo(Xr[i][c2]) * dtl[i], bfhi(Xr[i][c2]) * dtl[i]);
                        *(u16*)(XTs + swz(xo * 8 + 2 * c2, l)) = (u16)(pr & 0xFFFFu); *(u16*)(XTs + swz(xo * 8 + 2 * c2 + 1, l)) = (u16)(pr >> 16); } }
                if (tid < 128) { cum[tid] = cum128; dtv[tid] = dt128; }
            }
            if (ci + 1 < 66 && ci + 1 != 34) SSD_LOAD(ci + 1, tid);
            LDS_BARRIER();
            {
                bf16x8 afrag[4], gfrag[4];
#pragma unroll
                for (int kk = 0; kk < 4; ++kk) { afrag[kk] = *(const bf16x8*)(Cs + swz(wave * 16 + fr, kk * 32 + fq * 8)); gfrag[kk] = *(const bf16x8*)(Gs + swz(wave * 16 + fr, kk * 32 + fq * 8)); }
                const int l = wave * 16 + fr;
                const float e = __expf(cum[l]), rdt = Dh / dtv[l];
                u16* yrow = (ci < 2 && d == 1) ? YC1 + (size_t)(row0 - ML + l) * 2048 + xc0 : Y + (size_t)(row0 + l) * 2048 + xc0;
#pragma unroll
                for (int pt = 0; pt < 4; ++pt) {
                    f32x4 accD = (f32x4){0.f, 0.f, 0.f, 0.f}, accO = (f32x4){0.f, 0.f, 0.f, 0.f};
#pragma unroll
                    for (int kk = 0; kk < 4; ++kk) {
                        const bf16x8 xf = *(const bf16x8*)(XTs + swz(pt * 16 + fr, kk * 32 + fq * 8));
                        accD = __builtin_amdgcn_mfma_f32_16x16x32_bf16(xf, gfrag[kk], accD, 0, 0, 0);
                        const bf16x8 hb = *(const bf16x8*)(Hs + swz(pt * 16 + fr, kk * 32 + fq * 8));
                        accO = __builtin_amdgcn_mfma_f32_16x16x32_bf16(hb, afrag[kk], accO, 0, 0, 0);
                    }
                    const int p0 = pt * 16 + fq * 4;
                    float o[4];
                    if (ci >= 34) { const u32x2 yo = yold[pt];
                        o[0] = bflo(yo[0]) + accD[0] + e * accO[0]; o[1] = bfhi(yo[0]) + accD[1] + e * accO[1];
                        o[2] = bflo(yo[1]) + accD[2] + e * accO[2]; o[3] = bfhi(yo[1]) + accD[3] + e * accO[3]; }
                    else { const float dsk = (ci < 2 && d == 1) ? 0.f : rdt;
#pragma unroll
                        for (int jj = 0; jj < 4; ++jj) o[jj] = dsk * bf2f(*(const u16*)(XTs + swz(p0 + jj, l))) + accD[jj] + e * accO[jj]; }
                    u32x2 ov; ov[0] = pack2hw(o[0], o[1]); ov[1] = pack2hw(o[2], o[3]);
                    *(u32x2*)(yrow + p0) = ov;
                }
            }
            {
                if (ci + 1 < 66 && ci + 1 != 34) SSD_LOADY(ci + 1, tid);
                const float et = __expf(total);
                bf16x8 bb[4];
#pragma unroll
                for (int kk = 0; kk < 4; ++kk) bb[kk] = *(const bf16x8*)(BTs + swz(wave * 16 + fr, kk * 32 + fq * 8));
#pragma unroll
                for (int pt = 0; pt < 4; ++pt) {
                    f32x4 acc = hreg[pt] * et;
#pragma unroll
                    for (int kk = 0; kk < 4; ++kk) { const bf16x8 xf = *(const bf16x8*)(XTs + swz(pt * 16 + fr, kk * 32 + fq * 8));
                        acc = __builtin_amdgcn_mfma_f32_16x16x32_bf16(bb[kk], xf, acc, 0, 0, 0); }
                    hreg[pt] = acc;
                }
                LDS_BARRIER();
#pragma unroll
                for (int pt = 0; pt < 4; ++pt) { u32x2 hv; hv[0] = pack2hw(hreg[pt][0], hreg[pt][1]); hv[1] = pack2hw(hreg[pt][2], hreg[pt][3]);
                    *(u32x2*)(Hs + swz(pt * 16 + fr, wave * 16 + fq * 4)) = hv; }
            }
        }
#undef SSD_LOAD
#undef SSD_LOADY
#undef SSD_ROW0
    }
}
__device__ __forceinline__ void phase_ssd_gatenorm(const Params& p, int j) {
    const int lane = otid() & 63, gw = blockIdx.x * 8 + (otid() >> 6), nw = gridDim.x * 8;
    u16* Y = (u16*)(p.ws + OFF_Y); const u16* Z = (const u16*)(p.ws + OFF_Z); const float* ng = p.in[16] + (size_t)j * 2048;
    for (int row = gw; row < MT; row += nw) {
#pragma unroll
        for (int k = 0; k < 4; ++k) {
            const int c = k * 512 + lane * 8;
            const u32x4 yv = *(const u32x4*)(Y + (size_t)row * 2048 + c), zv = *(const u32x4*)(Z + (size_t)row * 2048 + c);
            float yf[8], zf[8], v[8]; unpack8(yv, yf); unpack8(zv, zf);
            if (row >= ML) { const u32x4 y1 = *(const u32x4*)((const u16*)(p.ws + OFF_YC1) + (size_t)(row - ML) * 2048 + c); float y1f[8]; unpack8(y1, y1f);
#pragma unroll
                for (int i = 0; i < 8; ++i) yf[i] += y1f[i]; }
            float ss = 0.f;
#pragma unroll
            for (int i = 0; i < 8; ++i) { v[i] = yf[i] * silu_f(zf[i]); ss += v[i] * v[i]; }
            ss = wave_sum(ss);
            const float rstd = rsqrtf(ss * (1.f / 512.f) + 1e-6f);
            const float4 g0 = *(const float4*)(ng + c), g1 = *(const float4*)(ng + c + 4);
            u32x4 o;
            o[0] = pack2(v[0] * rstd * g0.x, v[1] * rstd * g0.y); o[1] = pack2(v[2] * rstd * g0.z, v[3] * rstd * g0.w);
            o[2] = pack2(v[4] * rstd * g1.x, v[5] * rstd * g1.y); o[3] = pack2(v[6] * rstd * g1.z, v[7] * rstd * g1.w);
            *(u32x4*)(Y + (size_t)row * 2048 + c) = o;
        }
    }
}

template <int W> __device__ __forceinline__ void pool_lat_item(const u16* U, u16* PO, float* cs, size_t base, int r, int g, int cp, int cq) {
    const int HW = 1 << g;
#pragma unroll 2
    for (int ci = 0; ci < 16; ++ci) { const int c = cq + 4 * ci;
        u32 v[W];
#pragma unroll
        for (int k = 0; k < W; ++k) { const int rr = min(max(r - HW + k, 0), 127); v[k] = *(const u32*)(U + (base + rr * 64 + c) * 1024 + g * 256 + 2 * cp); }
        float s0 = 0.f, s1 = 0.f;
#pragma unroll
        for (int k = 0; k < W; ++k) { const int rr = r - HW + k; const float wt = (k < 2 * HW && rr >= 0 && rr < 128) ? 1.f : 0.f; s0 += wt * bflo(v[k]); s1 += wt * bfhi(v[k]); }
        cs[c * 256 + 2 * cp] = s0; cs[c * 256 + 2 * cp + 1] = s1; }
    __syncthreads();
    const int cnt_r = min(r + HW, 128) - max(r - HW, 0);
#pragma unroll 2
    for (int ci = 0; ci < 16; ++ci) { const int c = cq + 4 * ci;
        float s0 = 0.f, s1 = 0.f;
#pragma unroll
        for (int k = 0; k < W; ++k) { const int c2 = c - HW + k; const int cc = min(max(c2, 0), 63); const float wt = (k < 2 * HW && c2 >= 0 && c2 < 64) ? 1.f : 0.f;
            s0 += wt * cs[cc * 256 + 2 * cp]; s1 += wt * cs[cc * 256 + 2 * cp + 1]; }
        const int cnt_c = min(c + HW, 64) - max(c - HW, 0);
        const float inv = 1.f / ((float)cnt_r * (float)cnt_c);
        const size_t row = base + r * 64 + c;
        const u32 tk = *(const u32*)(U + row * 1024 + g * 256 + 2 * cp);
        *(u32*)(PO + row * 1024 + g * 256 + 2 * cp) = pack2(s0 * inv - bflo(tk), s1 * inv - bfhi(tk)); }
}
template <int W> __device__ __forceinline__ void pool_ctx_item(const u16* U, u16* PO, size_t base, int g, int cp, int cq) {
    const int HW = 1 << g;
#pragma unroll 2
    for (int i = 0; i < 64; ++i) { const int t = cq + 4 * i;
        u32 v[W];
#pragma unroll
        for (int k = 0; k < W; ++k) { const int sidx = min(max(t - HW + k, 0), 255); v[k] = *(const u32*)(U + (base + sidx) * 1024 + g * 256 + 2 * cp); }
        float s0 = 0.f, s1 = 0.f;
#pragma unroll
        for (int k = 0; k < W; ++k) { const int sidx = t - HW + k; const float wt = (k < 2 * HW && sidx >= 0 && sidx < 256) ? 1.f : 0.f; s0 += wt * bflo(v[k]); s1 += wt * bfhi(v[k]); }
        const float inv = 1.f / (float)(min(t + HW, 256) - max(t - HW, 0));
        const u32 tk = *(const u32*)(U + (base + t) * 1024 + g * 256 + 2 * cp);
        *(u32*)(PO + (base + t) * 1024 + g * 256 + 2 * cp) = pack2(s0 * inv - bflo(tk), s1 * inv - bfhi(tk)); }
}
__device__ __forceinline__ void phase_pool(const Params& p, unsigned char* lds) {
    float* cs = (float*)lds;
    const int tid = otid(), cp = tid & 127, cq = tid >> 7;
    const u16* U = (const u16*)(p.ws + OFF_U); u16* PO = (u16*)(p.ws + OFF_POOLED);
    for (int item = blockIdx.x; item < 2048 + 16; item += gridDim.x) {
        __syncthreads();
        if (item < 2048) {
            const int b = item >> 9, r = (item >> 2) & 127, g = item & 3;
            const size_t base = (size_t)b * 8192;
            if (g < 2) pool_lat_item<4>(U, PO, cs, base, r, g, cp, cq);
            else pool_lat_item<16>(U, PO, cs, base, r, g, cp, cq);
        } else {
            const int it = item - 2048, b = it >> 2, g = it & 3;
            const size_t base = (size_t)ML + b * 256;
            pool_ctx_item<16>(U, PO, base, g, cp, cq);
        }
    }
}

__device__ __forceinline__ float2 cmul(float2 a, float2 b) { return make_float2(a.x * b.x - a.y * b.y, a.x * b.y + a.y * b.x); }
__device__ __forceinline__ float2 twid(float turns) { return make_float2(__builtin_amdgcn_cosf(turns), __builtin_amdgcn_sinf(turns)); }
__device__ __forceinline__ void fft_fwd(const Params& p, float2* X) {
    const int tid = otid();
    for (int s = 8192; s >= 2; s >>= 2) {
        const int q = s >> 1, lq = __builtin_ctz(q); const float inv2s = 0.5f / (float)s, invs = 1.0f / (float)s;
#pragma unroll 4
        for (int it = 0; it < 8; ++it) {
            const int jx = tid + it * 512; const int grp = jx >> lq, pos = jx & (q - 1); const int i0 = grp * 2 * s + pos;
            const float2 a = X[i0], b = X[i0 + q], c = X[i0 + s], dd = X[i0 + s + q];
            const float2 tw = twid((float)pos * inv2s);
            const float2 w1 = make_float2(tw.x, -tw.y), w2 = make_float2(-tw.y, -tw.x), w3 = make_float2(tw.x * tw.x - tw.y * tw.y, -2.f * tw.x * tw.y);
            const float2 a1 = make_float2(a.x + c.x, a.y + c.y), c1 = cmul(make_float2(a.x - c.x, a.y - c.y), w1);
            const float2 b1 = make_float2(b.x + dd.x, b.y + dd.y), d1 = cmul(make_float2(b.x - dd.x, b.y - dd.y), w2);
            X[i0] = make_float2(a1.x + b1.x, a1.y + b1.y); X[i0 + q] = cmul(make_float2(a1.x - b1.x, a1.y - b1.y), w3);
            X[i0 + s] = make_float2(c1.x + d1.x, c1.y + d1.y); X[i0 + s + q] = cmul(make_float2(c1.x - d1.x, c1.y - d1.y), w3);
        }
        __syncthreads();
    }
}
__device__ __forceinline__ void fft_inv(const Params& p, float2* X) {
    const int tid = otid();
    for (int s = 2; s <= 8192; s <<= 2) {
        const int q = s >> 1, lq = __builtin_ctz(q); const float inv2s = 0.5f / (float)s, invs = 1.0f / (float)s;
#pragma unroll 4
        for (int it = 0; it < 8; ++it) {
            const int jx = tid + it * 512; const int grp = jx >> lq, pos = jx & (q - 1); const int i0 = grp * 2 * s + pos;
            const float2 a = X[i0], b = X[i0 + q], c = X[i0 + s], dd = X[i0 + s + q];
            const float2 w1 = twid((float)pos * inv2s), w2 = make_float2(-w1.y, w1.x), w3 = make_float2(w1.x * w1.x - w1.y * w1.y, 2.f * w1.x * w1.y);
            const float2 bw = cmul(b, w3), dw = cmul(dd, w3);
            const float2 a1 = make_float2(a.x + bw.x, a.y + bw.y), b1 = make_float2(a.x - bw.x, a.y - bw.y);
            const float2 c1 = make_float2(c.x + dw.x, c.y + dw.y), d1 = make_float2(c.x - dw.x, c.y - dw.y);
            const float2 cw = cmul(c1, w1), dw2 = cmul(d1, w2);
            X[i0] = make_float2(a1.x + cw.x, a1.y + cw.y); X[i0 + s] = make_float2(a1.x - cw.x, a1.y - cw.y);
            X[i0 + q] = make_float2(b1.x + dw2.x, b1.y + dw2.y); X[i0 + s + q] = make_float2(b1.x - dw2.x, b1.y - dw2.y);
        }
        __syncthreads();
    }
}
__device__ __forceinline__ int brev14(int k) { return (int)(__brev((unsigned)k) >> 18); }
__device__ __forceinline__ void spec_mul(const Params& p, float2* X, const float2* Ka, const float2* Kb) {
    const int tid = otid();
#pragma unroll 1
    for (int half = 0; half < 2; ++half) {
        float2 ka[8], kb[8];
#pragma unroll
        for (int i = 0; i < 8; ++i) { const int k = tid + 512 * (half * 8 + i); ka[i] = Ka[k]; kb[i] = Kb[k]; }
#pragma unroll
        for (int i = 0; i < 8; ++i) { const int k = tid + 512 * (half * 8 + i);
            const int pk = brev14(k), pm = brev14((16384 - k) & 16383);
            const float2 zk = X[pk], zm = X[pm];
            const float2 ua = make_float2(0.5f * (zk.x + zm.x), 0.5f * (zk.y - zm.y));
            const float2 ub = make_float2(0.5f * (zk.y + zm.y), -0.5f * (zk.x - zm.x));
            const float2 pa = cmul(ua, ka[i]), pb = cmul(ub, kb[i]);
            X[pk] = make_float2(pa.x - pb.y, pa.y + pb.x);
            X[pm] = make_float2(pa.x + pb.y, -pa.y + pb.x); }
    }
    if (tid == 0) { const int pk = brev14(8192);
        const float2 zk = X[pk];
        const float2 pa = cmul(make_float2(zk.x, 0.f), Ka[8192]), pb = cmul(make_float2(zk.y, 0.f), Kb[8192]);
        X[pk] = make_float2(pa.x - pb.y, pa.y + pb.x); }
    __syncthreads();
}
__device__ __forceinline__ void conv3x4(const u16* rowp, int n0, float w0, float w1, float w2, float bias, float (&out)[4]) {
    const u32x2 v = *(const u32x2*)(rowp + n0);
    const float c0 = bflo(v[0]), c1 = bfhi(v[0]), c2 = bflo(v[1]), c3 = bfhi(v[1]);
    const float l = n0 > 0 ? bf2f(rowp[n0 - 1]) : 0.f; const float r = n0 + 4 < 8192 ? bf2f(rowp[n0 + 4]) : 0.f;
    out[0] = bias + w0 * l + w1 * c0 + w2 * c1; out[1] = bias + w0 * c0 + w1 * c1 + w2 * c2;
    out[2] = bias + w0 * c1 + w1 * c2 + w2 * c3; out[3] = bias + w0 * c2 + w1 * c3 + w2 * r;
}
__device__ __forceinline__ float conv3_at(const u16* rowp, int n, int L, float w0, float w1, float w2, float bias) {
    const float c = bf2f(rowp[n]); const float l = n > 0 ? bf2f(rowp[n - 1]) : 0.f; const float r = n < L - 1 ? bf2f(rowp[n + 1]) : 0.f;
    return bias + w0 * l + w1 * c + w2 * r;
}
__device__ __forceinline__ void phase_hyena_lat(const Params& p, unsigned char* lds) {
    float2* X = (float2*)lds; float* aux = (float*)(lds + 131072);
    float* w3s = aux; float* red = aux + 512;
    const int tid = otid(), lane = tid & 63, wave = tid >> 6;
    const u16* PT = (const u16*)(p.ws + OFF_PT); u16* YT = (u16*)(p.ws + OFF_YT);
    float2* KF = (float2*)(p.ws + OFF_KF) + (size_t)blockIdx.x * 4 * KF_STRIDE;
    float2* ZS = (float2*)(p.ws + OFF_ZS) + (size_t)blockIdx.x * 8192;
    const float* HID2 = (const float*)(p.ws + OFF_HID2); const float* fw3 = p.in[28];
    for (int pair = blockIdx.x; pair < 512; pair += gridDim.x) {
        const int cha = 2 * pair;
        {
            float2* K1 = KF + (size_t)2 * KF_STRIDE;
            __syncthreads();
            { const int o = tid >> 8, which = (tid >> 6) & 3, jj = tid & 63; const int ch = cha + (which >> 1), dir = which & 1;
              w3s[tid] = fw3[(size_t)jj * 4096 + (o * 2 + dir) * 1024 + ch]; }
            __syncthreads();
            const float dela = 3.0701134573253945f + (float)cha * (12.280453829301578f / 1023.f);
            const float delb = 3.0701134573253945f + (float)(cha + 1) * (12.280453829301578f / 1023.f);
            float ss0a = 0.f, ss0b = 0.f, ss1a = 0.f, ss1b = 0.f;
#pragma unroll 1
            for (int i = 0; i < 16; ++i) {
                const int pos = tid + 512 * i;
                const float4* hr = (const float4*)(HID2 + (size_t)pos * 64);
                float d[8]; float4 hv[16];
#pragma unroll
                for (int q4 = 0; q4 < 16; ++q4) hv[q4] = hr[q4];
#pragma unroll
                for (int c = 0; c < 8; ++c) { float acc = 0.f; const float* wc = w3s + c * 64;
#pragma unroll
                    for (int q4 = 0; q4 < 16; ++q4) acc += hv[q4].x * wc[q4 * 4] + hv[q4].y * wc[q4 * 4 + 1] + hv[q4].z * wc[q4 * 4 + 2] + hv[q4].w * wc[q4 * 4 + 3];
                    asm volatile("" : "+v"(acc));
                    d[c] = acc; }
                const float t = (float)pos / 8191.f; const float ea = __expf(-t * dela), eb = __expf(-t * delb);
                const float h0a = d[0] * ea, h1a = d[1] * ea, h0b = d[2] * eb, h1b = d[3] * eb;
                const float g0a = d[4] * ea, g1a = d[5] * ea, g0b = d[6] * eb, g1b = d[7] * eb;
                ss0a += h0a * h0a + h1a * h1a; ss0b += h0b * h0b + h1b * h1b; ss1a += g0a * g0a + g1a * g1a; ss1b += g0b * g0b + g1b * g1b;
                X[pos] = make_float2(h0a, h0b); K1[pos] = make_float2(g0a, g0b);
                if (pos >= 1) { X[16384 - pos] = make_float2(h1a, h1b); K1[16384 - pos] = make_float2(g1a, g1b); }
            }
            if (tid == 0) { const float4 z4 = zerof4(); X[8192] = make_float2(z4.x, z4.y); K1[8192] = make_float2(z4.x, z4.y); }
            ss0a = wave_sum(ss0a); ss0b = wave_sum(ss0b); ss1a = wave_sum(ss1a); ss1b = wave_sum(ss1b);
            if (lane == 0) { red[wave] = ss0a; red[8 + wave] = ss0b; red[16 + wave] = ss1a; red[24 + wave] = ss1b; }
            __syncthreads();
#pragma unroll 1
            for (int o = 0; o < 2; ++o) {
                float ta = 0.f, tb = 0.f;
#pragma unroll
                for (int w = 0; w < 8; ++w) { ta += red[o * 16 + w]; tb += red[o * 16 + 8 + w]; }
                const float sa = rsqrtf(ta + 1e-6f), sb = rsqrtf(tb + 1e-6f);
                if (o == 1) {
                    __syncthreads();
                    float4* X4 = (float4*)X; const float4* K4 = (const float4*)(KF + (size_t)2 * KF_STRIDE);
#pragma unroll
                    for (int i = 0; i < 16; ++i) X4[tid + 512 * i] = K4[tid + 512 * i];
                    __syncthreads();
                }
                fft_fwd(p, X);
                float2* Ka = KF + (size_t)(o * 2) * KF_STRIDE; float2* Kb = Ka + KF_STRIDE;
                for (int k = tid; k <= 8192; k += 512) {
                    const int pk = brev14(k), pm = brev14((16384 - k) & 16383);
                    const float2 zk = X[pk], zm = X[pm];
                    Ka[k] = make_float2(sa * 0.5f * (zk.x + zm.x), sa * 0.5f * (zk.y - zm.y));
                    Kb[k] = make_float2(sb * 0.5f * (zk.y + zm.y), -sb * 0.5f * (zk.x - zm.x));
                }
            }
        }
        __threadfence_block();
        __syncthreads();
        const float* cw = p.in[22]; const float* cb = p.in[23]; const float* hbias = p.in[30];
        int tidc = tid; asm volatile("" : "+v"(tidc));
        float wv[2][3][4];
#pragma unroll
        for (int ab = 0; ab < 2; ++ab)
#pragma unroll
            for (int part = 0; part < 3; ++part) { const int cidx = part * 1024 + cha + ab;
                wv[ab][part][0] = cw[cidx]; wv[ab][part][1] = cw[3072 + cidx]; wv[ab][part][2] = cw[6144 + cidx]; wv[ab][part][3] = cb[cidx]; }
        const float hb0a = hbias[cha], hb0b = hbias[cha + 1], hb1a = hbias[1024 + cha], hb1b = hbias[1024 + cha + 1];
        for (int b = 0; b < 4; ++b) {
            const u16* va = PT + (size_t)cha * MT + (size_t)b * 8192; const u16* vb = va + MT;
            const u16* x1a = va + (size_t)1024 * MT; const u16* x1b = x1a + MT;
            const u16* x2a = va + (size_t)2048 * MT; const u16* x2b = x2a + MT;
            __syncthreads();
            float4* X4 = (float4*)X; float4* ZS4 = (float4*)ZS;
#pragma unroll
            for (int g = 0; g < 4; ++g) { const int n0 = 4 * (tidc + 512 * g);
                float a[4], c[4];
                conv3x4(va, n0, wv[0][0][0], wv[0][0][1], wv[0][0][2], wv[0][0][3], a); conv3x4(vb, n0, wv[1][0][0], wv[1][0][1], wv[1][0][2], wv[1][0][3], c);
                X4[n0 >> 1] = make_float4(a[0], c[0], a[1], c[1]); X4[(n0 >> 1) + 1] = make_float4(a[2], c[2], a[3], c[3]);
                X4[4096 + (n0 >> 1)] = zerof4(); X4[4096 + (n0 >> 1) + 1] = zerof4(); }
            __syncthreads();
            fft_fwd(p, X);
            spec_mul(p, X, KF, KF + KF_STRIDE);
            fft_inv(p, X);
#pragma unroll
            for (int g = 0; g < 4; ++g) { const int n0 = 4 * (tidc + 512 * g);
                float a[4], c[4], xa[4], xb[4];
                conv3x4(va, n0, wv[0][0][0], wv[0][0][1], wv[0][0][2], wv[0][0][3], a); conv3x4(vb, n0, wv[1][0][0], wv[1][0][1], wv[1][0][2], wv[1][0][3], c);
                conv3x4(x1a, n0, wv[0][1][0], wv[0][1][1], wv[0][1][2], wv[0][1][3], xa); conv3x4(x1b, n0, wv[1][1][0], wv[1][1][1], wv[1][1][2], wv[1][1][3], xb);
                const float4 q0 = X4[n0 >> 1], q1 = X4[(n0 >> 1) + 1];
                const float4 z0 = make_float4(xa[0] * (q0.x * (1.f / 16384.f) + a[0] * hb0a), xb[0] * (q0.y * (1.f / 16384.f) + c[0] * hb0b),
                                              xa[1] * (q0.z * (1.f / 16384.f) + a[1] * hb0a), xb[1] * (q0.w * (1.f / 16384.f) + c[1] * hb0b));
                const float4 z1 = make_float4(xa[2] * (q1.x * (1.f / 16384.f) + a[2] * hb0a), xb[2] * (q1.y * (1.f / 16384.f) + c[2] * hb0b),
                                              xa[3] * (q1.z * (1.f / 16384.f) + a[3] * hb0a), xb[3] * (q1.w * (1.f / 16384.f) + c[3] * hb0b));
                ZS4[n0 >> 1] = z0; ZS4[(n0 >> 1) + 1] = z1; X4[n0 >> 1] = z0; X4[(n0 >> 1) + 1] = z1;
                X4[4096 + (n0 >> 1)] = zerof4(); X4[4096 + (n0 >> 1) + 1] = zerof4(); }
            __syncthreads();
            fft_fwd(p, X);
            spec_mul(p, X, KF + 2 * KF_STRIDE, KF + 3 * KF_STRIDE);
            fft_inv(p, X);
#pragma unroll
            for (int g = 0; g < 4; ++g) { const int n0 = 4 * (tidc + 512 * g);
                float xa[4], xb[4];
                conv3x4(x2a, n0, wv[0][2][0], wv[0][2][1], wv[0][2][2], wv[0][2][3], xa); conv3x4(x2b, n0, wv[1][2][0], wv[1][2][1], wv[1][2][2], wv[1][2][3], xb);
                const float4 q0 = X4[n0 >> 1], q1 = X4[(n0 >> 1) + 1]; const float4 z0 = ZS4[n0 >> 1], z1 = ZS4[(n0 >> 1) + 1];
                u32x2 oa, ob;
                oa[0] = pack2(xa[0] * (q0.x * (1.f / 16384.f) + z0.x * hb1a), xa[1] * (q0.z * (1.f / 16384.f) + z0.z * hb1a));
                oa[1] = pack2(xa[2] * (q1.x * (1.f / 16384.f) + z1.x * hb1a), xa[3] * (q1.z * (1.f / 16384.f) + z1.z * hb1a));
                ob[0] = pack2(xb[0] * (q0.y * (1.f / 16384.f) + z0.y * hb1b), xb[1] * (q0.w * (1.f / 16384.f) + z0.w * hb1b));
                ob[1] = pack2(xb[2] * (q1.y * (1.f / 16384.f) + z1.y * hb1b), xb[3] * (q1.w * (1.f / 16384.f) + z1.w * hb1b));
                *(u32x2*)(YT + (size_t)cha * MT + (size_t)b * 8192 + n0) = oa;
                *(u32x2*)(YT + (size_t)(cha + 1) * MT + (size_t)b * 8192 + n0) = ob; }
        }
    }
}
__device__ __forceinline__ void phase_hyena_ctx(const Params& p, unsigned char* lds) {
    float* kf = (float*)lds;
    float* vs = kf + 1024; float* x1s = vs + 1024; float* x2s = x1s + 1024; float* zs = x2s + 1024; float* red = zs + 1024;
    const int tid = otid(), lane = tid & 63, wave = tid >> 6;
    const u16* PT = (const u16*)(p.ws + OFF_PT); u16* YT = (u16*)(p.ws + OFF_YT);
    const float* HID2C = (const float*)(p.ws + OFF_HID2C); const float* fw3 = p.in[28];
    const float* cw = p.in[22]; const float* cb = p.in[23]; const float* hbias = p.in[30];
    for (int ch = blockIdx.x; ch < 1024; ch += gridDim.x) {
        __syncthreads();
        {
            const int pos = tid & 255, o = tid >> 8;
            float* w3c = red + 16;
            if (tid < 256) w3c[tid] = fw3[(size_t)(tid & 63) * 4096 + (tid >> 6) * 1024 + ch];
            float4 hrow[16];
#pragma unroll
            for (int q4 = 0; q4 < 16; ++q4) hrow[q4] = *(const float4*)(HID2C + (size_t)pos * 64 + q4 * 4);
            __syncthreads();
            float d0 = 0.f, d1 = 0.f;
#pragma unroll
            for (int q4 = 0; q4 < 16; ++q4) { const float* wa = w3c + (o * 2) * 64 + q4 * 4; const float* wb = wa + 64;
                d0 += hrow[q4].x * wa[0] + hrow[q4].y * wa[1] + hrow[q4].z * wa[2] + hrow[q4].w * wa[3];
                d1 += hrow[q4].x * wb[0] + hrow[q4].y * wb[1] + hrow[q4].z * wb[2] + hrow[q4].w * wb[3]; }
            const float del = 3.0701134573253945f + (float)ch * (12.280453829301578f / 1023.f);
            const float e = __expf(-((float)pos / 255.f) * del);
            const float h0 = d0 * e, h1 = d1 * e;
            float ss = wave_sum(h0 * h0 + h1 * h1);
            if (lane == 0) red[wave] = ss;
            __syncthreads();
            const float tot = red[o * 4] + red[o * 4 + 1] + red[o * 4 + 2] + red[o * 4 + 3];
            const float sc = rsqrtf(tot + 1e-6f);
            kf[(o * 2) * 256 + pos] = h0 * sc; kf[(o * 2 + 1) * 256 + pos] = h1 * sc;
        }
        const float w00 = cw[ch], w01 = cw[3072 + ch], w02 = cw[6144 + ch], b0 = cb[ch];
        const float w10 = cw[1024 + ch], w11 = cw[3072 + 1024 + ch], w12 = cw[6144 + 1024 + ch], b1 = cb[1024 + ch];
        const float w20 = cw[2048 + ch], w21 = cw[3072 + 2048 + ch], w22 = cw[6144 + 2048 + ch], b2 = cb[2048 + ch];
        const float hb0 = hbias[ch], hb1 = hbias[1024 + ch];
#pragma unroll
        for (int r = 0; r < 2; ++r) { const int idx = tid + 512 * r, bb = idx >> 8, l = idx & 255;
            const u16* base = PT + (size_t)ch * MT + ML + bb * 256;
            vs[idx] = conv3_at(base, l, 256, w00, w01, w02, b0);
            x1s[idx] = conv3_at(base + (size_t)1024 * MT, l, 256, w10, w11, w12, b1);
            x2s[idx] = conv3_at(base + (size_t)2048 * MT, l, 256, w20, w21, w22, b2); }
        __syncthreads();
#pragma unroll
        for (int r = 0; r < 2; ++r) { const int idx = tid + 512 * r, bb = idx >> 8, l = idx & 255;
            float c = 0.f;
            for (int s = 0; s <= l; ++s) c += kf[l - s] * vs[bb * 256 + s];
            for (int s = l + 1; s < 256; ++s) c += kf[256 + s - l] * vs[bb * 256 + s];
            zs[idx] = x1s[idx] * (c + vs[idx] * hb0); }
        __syncthreads();
#pragma unroll
        for (int r = 0; r < 2; ++r) { const int idx = tid + 512 * r, bb = idx >> 8, l = idx & 255;
            float c = 0.f;
            for (int s = 0; s <= l; ++s) c += kf[512 + l - s] * zs[bb * 256 + s];
            for (int s = l + 1; s < 256; ++s) c += kf[768 + s - l] * zs[bb * 256 + s];
            YT[(size_t)ch * MT + ML + idx] = f2bf(x2s[idx] * (c + zs[idx] * hb1)); }
    }
}
__device__ __forceinline__ void phase_transpose_y(const Params& p, unsigned char* lds) {
    u16* tile = (u16*)lds;
    const int tid = otid();
    const u16* YT = (const u16*)(p.ws + OFF_YT); u16* Yh = (u16*)(p.ws + OFF_U);
    u32 v[4], nv[4];
    int t = blockIdx.x;
    if (t < 16 * 528) { const int c0 = (t / 528) << 6, r0 = (t % 528) << 6;
#pragma unroll
        for (int r = 0; r < 4; ++r) v[r] = *(const u32*)(YT + (size_t)(c0 + (tid >> 5) + 16 * r) * MT + r0 + (tid & 31) * 2); }
    for (; t < 16 * 528; t += gridDim.x) {
        const int c0 = (t / 528) << 6, r0 = (t % 528) << 6;
        const int tn = t + (int)gridDim.x;
        if (tn < 16 * 528) { const int c1 = (tn / 528) << 6, r1 = (tn % 528) << 6;
#pragma unroll
            for (int r = 0; r < 4; ++r) nv[r] = *(const u32*)(YT + (size_t)(c1 + (tid >> 5) + 16 * r) * MT + r1 + (tid & 31) * 2); }
        LDS_BARRIER();
#pragma unroll
        for (int r = 0; r < 4; ++r) { const int i = (tid >> 5) + 16 * r, j2 = (tid & 31) * 2; tile[i * 66 + j2] = (u16)(v[r] & 0xFFFFu); tile[i * 66 + j2 + 1] = (u16)(v[r] >> 16); }
        LDS_BARRIER();
#pragma unroll
        for (int r = 0; r < 4; ++r) { const int jt = (tid >> 5) + 16 * r, c2 = (tid & 31) * 2;
            *(u32*)(Yh + (size_t)(r0 + jt) * 1024 + c0 + c2) = (u32)tile[c2 * 66 + jt] | ((u32)tile[(c2 + 1) * 66 + jt] << 16); }
#pragma unroll
        for (int r = 0; r < 4; ++r) v[r] = nv[r];
    }
}

__global__ void __launch_bounds__(512, 2) hybrid_fwd(KArgs ka) {
    extern __shared__ __attribute__((aligned(16))) unsigned char shm[];
    cg::grid_group grid = cg::this_grid();
    Params p; p.in = (const float* const*)(ka.ws + OFF_TAB); p.out = ka.out; p.ws = ka.ws; p.wave = __builtin_amdgcn_readfirstlane((int)threadIdx.x >> 6);
    volatile PG8_LAS unsigned* st = (volatile PG8_LAS unsigned*)((PG8_LAS unsigned char*)shm + (LDS_BYTES - 16));
    if (threadIdx.x == 0) { st[0] = 0u; st[1] = 0u; }
    __syncthreads();
    (void)xcd_barrier_post((unsigned*)(p.ws + OFF_BAR), st);
#if PROBE
    unsigned long long* TS = (unsigned long long*)(p.ws + OFF_TS); int nsync = 0;
#define STAMP() do { if (blockIdx.x == 0 && threadIdx.x == 0) TS[nsync] = wall_clock64(); ++nsync; } while (0)
#else
#define STAMP() do { } while (0)
#endif
#define SYNC() do { XcdBarrier xb_; xb_.bar = (unsigned*)(p.ws + OFF_BAR); xb_.x = xb_xcc_id(); xb_.wave = p.wave; xb_.st = (volatile PG8_LAS unsigned*)((PG8_LAS unsigned char*)shm + (LDS_BYTES - 16)); xcd_barrier(xb_); STAMP(); asm volatile("" : "+s"(p.ws), "+s"(p.out), "+s"(p.in)); } while (0)
    u16* U = (u16*)(p.ws + OFF_U);
    float* Hc = (float*)(p.ws + OFF_HC);
    phase_setup(ka, shm, p.wave);
    grid.sync();
    STAMP();
    phase_modreduce(p);
    SYNC();
    int prev_nslice = 0;
#pragma unroll 1
    for (int layer = 0; layer < 4; ++layer) {
        const int kind = layer % 3, j = layer / 3;
        const float* modl = (const float*)(p.ws + OFF_MOD) + (size_t)layer * 5 * 9216;
#pragma unroll 1
        for (int sub = 0; sub < 3; ++sub) {
            if (sub == 0) convert_layer(p, layer, shm);
            const bool first = layer == 0 && sub == 0;
            phase_modulate(p, layer, sub, prev_nslice, first);
            SYNC();
            const u16* RA; const u16* RB; int RK; const float* rbias = (const float*)(p.ws + OFF_CONST); const float* rscale = rbias + 1024; float gmul;
            if (sub != 1) {
                const int f = sub == 0 ? 0 : 1;
                EpiFFN1 e1; e1.H = (u16*)(p.ws + OFF_HID);
                run_gemm(p.wave, shm, U, (const u16*)(p.ws + (f ? OFF_WGU1 : OFF_WGU0)), (layer == 3 && sub == 2) ? ML : MT, 5632, 1024, e1);
                SYNC();
                RA = (const u16*)(p.ws + OFF_HID); RB = (const u16*)(p.ws + (f ? OFF_WD1 : OFF_WD0)); RK = FF; gmul = 0.5f;
            } else {
                gmul = 1.0f;
                if (kind == 0) {
                    EpiSSDin es; es.Z = (u16*)(p.ws + OFF_Z); es.XBC = (u16*)(p.ws + OFF_XBC); es.DT = (float*)(p.ws + OFF_DT);
                    run_gemm(p.wave, shm, U, (const u16*)(p.ws + OFF_WM1), MT, 5376, 1024, es);
                    SYNC();
                    phase_ssd_prep1(p, j);
                    SYNC();
                    phase_ssd_prep2(p, j);
                    SYNC();
                    phase_ssd_cb(p, shm);
                    SYNC();
                    phase_ssd_scan(p, j, shm);
#if DBL_SCAN
                    if (layer == 0) phase_ssd_scan(p, j, shm);
#endif
                    SYNC();
                    phase_ssd_gatenorm(p, j);
                    SYNC();
                    RA = (const u16*)(p.ws + OFF_Y); RB = (const u16*)(p.ws + OFF_WM2); RK = 2048;
                } else if (kind == 1) {
                    phase_pool(p, shm);
                    SYNC();
                    RA = (const u16*)(p.ws + OFF_POOLED); RB = (const u16*)(p.ws + OFF_WM1); RK = 1024; rbias = p.in[19]; rscale = p.in[20];
                } else {
                    EpiBf16T et; et.O = (u16*)(p.ws + OFF_PT); et.ldc = MT;
                    run_gemm(p.wave, shm, (const u16*)(p.ws + OFF_WM1), U, 3072, MT, 1024, et);
                    SYNC();
                    phase_hyena_lat(p, shm);
#if DBL_HY
                    phase_hyena_lat(p, shm);
#endif
                    phase_hyena_ctx(p, shm);
                    SYNC();
                    phase_transpose_y(p, shm);
                    SYNC();
                    RA = U; RB = (const u16*)(p.ws + OFF_WM2); RK = 1024;
                }
            }
            {
                const bool ctx_live = !(layer == 3 && sub >= 1);
                const int nslice = RK >> 8, piece = (int)blockIdx.x;
                OneUnit os; os.has = ctx_live && piece < 16 * nslice;
                const int unit = os.has ? piece / nslice : 0, slice = os.has ? piece - unit * nslice : 0;
                os.u.pm = 128 + (unit >> 2); os.u.pn = unit & 3;
                const float* zeros = (const float*)(p.ws + OFF_CONST);
                const EpiResidPart ea{(float*)(p.ws + OFF_CPART) + (size_t)slice * 1024 * 1024, modl + (3 * sub + 2) * 1024, slice == 0 ? rbias : zeros, rscale, gmul, 0.f};
                Gemm g; g.A = RA + slice * 256; g.Bt = RB + slice * 256; g.M = MT; g.N = 1024; g.K = 256; g.ld = RK; g.wave = p.wave;
                gemm_phase<EpiResidPart, OneUnit>((PG8_LAS unsigned char*)shm, g, os, ea);
                prev_nslice = ctx_live ? nslice : 0;
            }
            const EpiResid er{p.out, first ? p.in[0] : (const float*)p.out, modl + (3 * sub + 2) * 1024, rbias, rscale, gmul, 0.f};
            run_gemm(p.wave, shm, RA, RB, ML, 1024, RK, er);
            SYNC();
        }
    }
    phase_final(p);
#if PROBE
    SYNC();
    if (blockIdx.x == 0) {
        const float t1 = (float)(TS[PROBE_P1] - TS[PROBE_P1 - 1]) * 0.01f, t2 = (float)(TS[PROBE_P2] - TS[PROBE_P2 - 1]) * 0.01f;
        if (threadIdx.x == 0) p.out[0] = 32.f * t1;
        for (int i = threadIdx.x; i < (1 << 20); i += 512) p.out[(1 << 20) + i] += t2;
    }
#endif
}

extern "C" void kernel_launch(void* const* d_in, const int* in_sizes, int n_in, void* d_out, int out_size, void* d_ws, size_t ws_size, hipStream_t stream) {
    static int grid_blocks = 0;
    if (grid_blocks == 0) {
        if (n_in != 33 || out_size != ML * 1024 || ws_size < WS_END) { fprintf(stderr, "kernel_launch: unexpected problem (n_in %d, out %d, ws %zu < %zu)\n", n_in, out_size, ws_size, (size_t)WS_END); grid_blocks = -1; return; }
        int dev = 0, cus = 0, per_cu = 0;
        hipGetDevice(&dev);
        hipDeviceGetAttribute(&cus, hipDeviceAttributeMultiprocessorCount, dev);
        if (hipFuncSetAttribute((const void*)hybrid_fwd, hipFuncAttributeMaxDynamicSharedMemorySize, LDS_BYTES) != hipSuccess) { fprintf(stderr, "kernel_launch: hipFuncSetAttribute failed\n"); grid_blocks = -1; return; }
        hipOccupancyMaxActiveBlocksPerMultiprocessor(&per_cu, (const void*)hybrid_fwd, 512, LDS_BYTES);
        if (per_cu < 1) { fprintf(stderr, "kernel_launch: occupancy query says %d blocks per CU\n", per_cu); per_cu = 1; }
        (void)hipGetLastError();
        if (cus < 256) { fprintf(stderr, "kernel_launch: this kernel is built for a 256-CU device (found %d CUs)\n", cus); grid_blocks = -1; return; }
        grid_blocks = 256;
    }
    if (grid_blocks < 0) return;
    KArgs p{};
    for (int i = 0; i < 33; ++i) p.in[i] = (const float*)d_in[i];
    p.out = (float*)d_out; p.ws = (unsigned char*)d_ws;
    if (hipMemsetAsync((char*)d_ws + OFF_BAR, 0, 16384, stream) != hipSuccess) { fprintf(stderr, "kernel_launch: memset failed\n"); return; }
    void* args[] = {&p};
    hipError_t e = hipLaunchCooperativeKernel((const void*)hybrid_fwd, dim3(grid_blocks), dim3(512), args, LDS_BYTES, stream);
    if (e != hipSuccess) fprintf(stderr, "cooperative launch failed: %s (grid %d)\n", hipGetErrorString(e), grid_blocks);
}
```

```cpp
#include <hip/hip_runtime.h>
#include <hip/hip_cooperative_groups.h>
#include <cstdio>
namespace cg = cooperative_groups;
__device__ __forceinline__ unsigned lane_id_now() { unsigned m = ~0u; asm volatile("" : "+v"(m)); return __builtin_amdgcn_mbcnt_hi(m, __builtin_amdgcn_mbcnt_lo(m, 0u)); }

#ifndef PROBE
#define PROBE 0
#endif
#ifndef PROBE_P1
#define PROBE_P1 7
#define PROBE_P2 27
#endif

#ifndef DBL_SCAN
#define DBL_SCAN 0
#endif
#ifndef DBL_HY
#define DBL_HY 0
#endif

namespace pg8 {
#define PG8_LAS __attribute__((address_space(3)))
typedef unsigned short bf16_t;
typedef short bf16x8 __attribute__((ext_vector_type(8)));
typedef float f32x4 __attribute__((ext_vector_type(4)));
typedef unsigned u32x4 __attribute__((ext_vector_type(4)));
constexpr int BM = 256, BK = 64, HALF = 128, HTB = HALF * BK * 2  , STAGE_BYTES = 8 * HTB, NXCD = 8, WGM = 8;

__host__ __device__ __forceinline__ int lds_byte(int r, int c) { const int st = (r >> 4) * 2 + (c >> 5), rr = r & 15, cc = c & 31, ob = rr * 64 + cc * 2; return st * 1024 + (ob ^ (((ob >> 9) & 1) << 5)); }
__host__ __device__ __forceinline__ void stage_rc(int b, int& R, int& C) { const int st = b / 1024, sb = b % 1024, swz = sb ^ (((sb >> 9) & 1) << 5); R = (st >> 1) * 16 + swz / 64; C = (st & 1) * 32 + (swz % 64) / 2; }
__host__ __device__ __forceinline__ int perm32(int rho) { const int n = rho >> 4, i = rho & 15; return 8 * (i >> 2) + 4 * n + (i & 3); }

struct Unit { int pm, pn; };
struct Gemm { const bf16_t* A; const bf16_t* Bt; int M, N, K, ld, wave; };
struct StaticOrder {
    int nM, nN, nwg, G, c;
    __host__ __device__ void init(int M, int N, int G_, int c_) { nM = M / BM; nN = N / BM; nwg = nM * nN; G = G_; c = c_; }
    __host__ __device__ bool next(int i, Unit& u) const {
        const long L = (long)i * G + c; if (L >= nwg) return false;
        int wgid = (int)L; { const int q = nwg / NXCD, r = nwg % NXCD, xcd = wgid % NXCD, off = wgid / NXCD; wgid = (xcd < r ? xcd * (q + 1) : r * (q + 1) + (xcd - r) * q) + off; }
        const int nig = WGM * nN, gid = wgid / nig, fm = gid * WGM, gsz = (nM - fm) < WGM ? (nM - fm) : WGM;
        u.pm = fm + ((wgid % nig) % gsz); u.pn = (wgid % nig) / gsz; return true;
    }
    __device__ __forceinline__ void a_ready(const Unit&) const {}
    __device__ __forceinline__ void done(const Unit&) const {}
};
__device__ __forceinline__ unsigned cvt_pk_bf16(float lo, float hi) { unsigned r; asm volatile("v_cvt_pk_bf16_f32 %0, %1, %2" : "=v"(r) : "v"(lo), "v"(hi)); return r; }
template <class Epi, class Sched>
__device__ __forceinline__ void gemm_phase(PG8_LAS unsigned char* lds, const Gemm g, const Sched S, const Epi E) {
    int tid_ = g.wave * 64 + (int)lane_id_now(); asm volatile("" : "+v"(tid_));
    const int tid = tid_, wid = __builtin_amdgcn_readfirstlane(tid >> 6), lane = tid & 63, wr = wid >> 2, wc = wid & 3, fr = lane & 15, fq = lane >> 4;
    const int K = g.K, nt = K / BK, LD = g.ld;
    unsigned voffA[2], voffB[2];
#pragma unroll
    for (int i = 0; i < 2; ++i) { int R, C; stage_rc(tid * 16 + i * 8192, R, C); const int Rb = Epi::PERM ? ((R & ~31) + perm32(R & 31)) : R;
        voffA[i] = (unsigned)(R * LD + C) * 2u; voffB[i] = (unsigned)(Rb * LD + C) * 2u; }
    const size_t kstep = (size_t)(BK * 2);
    const size_t hstep = (size_t)HALF * LD * 2;
    const size_t tstep = 2 * hstep;
    const unsigned ldsw = (unsigned)wid * 1024u;
    const int aoff = lds_byte(wr * 64 + fr, fq * 8), boff = lds_byte(wc * 32 + fr, fq * 8);
#define PG8_SA(b, h) (((b) * 2 + (h)) * HTB)
#define PG8_SB(b, h) ((4 + (b) * 2 + (h)) * HTB)
#define PG8_STAGE(bufoff, gbase, voff) do { _Pragma("unroll") for (int _i = 0; _i < 2; ++_i) \
        __builtin_amdgcn_global_load_lds((const unsigned*)((const char*)(gbase) + (voff)[_i]), (PG8_LAS unsigned*)(lds + (bufoff) + ldsw + _i * 8192), 16, 0, 0); } while (0)
#define PG8_LDA(dst, b, h) do { _Pragma("unroll") for (int m = 0; m < 4; ++m) _Pragma("unroll") for (int k = 0; k < 2; ++k) dst[m][k] = *(const PG8_LAS bf16x8*)(lds + PG8_SA(b, h) + aoff + m * 2048 + k * 1024); } while (0)
#define PG8_LDB(dst, b, h) do { _Pragma("unroll") for (int n = 0; n < 2; ++n) _Pragma("unroll") for (int k = 0; k < 2; ++k) dst[n][k] = *(const PG8_LAS bf16x8*)(lds + PG8_SB(b, h) + boff + n * 2048 + k * 1024); } while (0)
#define PG8_MMA(ai, bj, At, Bt) do { __builtin_amdgcn_s_setprio(1); _Pragma("unroll") for (int m = 0; m < 4; ++m) _Pragma("unroll") for (int n = 0; n < 2; ++n) _Pragma("unroll") for (int k = 0; k < 2; ++k) \
        acc[ai][bj][m][n] = __builtin_amdgcn_mfma_f32_16x16x32_bf16(Bt[n][k], At[m][k], acc[ai][bj][m][n], 0, 0, 0); __builtin_amdgcn_s_setprio(0); } while (0)
#define PG8_WAIT_V(n) asm volatile("s_waitcnt vmcnt(" #n ")" ::: "memory")
#define PG8_WAIT_L(n) asm volatile("s_waitcnt lgkmcnt(" #n ")" ::: "memory")
#define PG8_BAR __builtin_amdgcn_s_barrier()
#define PG8_SCHED __builtin_amdgcn_sched_barrier(0)
    Unit cur, nxt; int ui = 0;
    if (!S.next(0, cur)) return;
    f32x4 acc[2][2][4][2];
#pragma unroll
    for (int a = 0; a < 2; ++a)
#pragma unroll
        for (int b = 0; b < 2; ++b)
#pragma unroll
            for (int m = 0; m < 4; ++m)
#pragma unroll
                for (int n = 0; n < 2; ++n) acc[a][b][m][n] = (f32x4){0.f, 0.f, 0.f, 0.f};
    bf16x8 At[4][2], B0[2][2], B1[2][2];
    const char* cA = (const char*)g.A + (size_t)cur.pm * tstep; const char* cB = (const char*)g.Bt + (size_t)cur.pn * tstep;
    S.a_ready(cur);
    PG8_STAGE(PG8_SB(0, 0), cB, voffB); PG8_STAGE(PG8_SA(0, 0), cA, voffA); PG8_STAGE(PG8_SB(0, 1), cB + hstep, voffB); PG8_STAGE(PG8_SA(0, 1), cA + hstep, voffA);
    if (wr == 1) PG8_BAR;
    PG8_WAIT_V(4); PG8_BAR;
    PG8_STAGE(PG8_SB(1, 0), cB + kstep, voffB); PG8_STAGE(PG8_SA(1, 0), cA + kstep, voffA); PG8_STAGE(PG8_SB(1, 1), cB + hstep + kstep, voffB);
    PG8_WAIT_V(6); PG8_BAR;
    for (;;) {
        const bool has_next = S.next(ui + 1, nxt);
        const char* nA = has_next ? (const char*)g.A + (size_t)nxt.pm * tstep : cA; const char* nB = has_next ? (const char*)g.Bt + (size_t)nxt.pn * tstep : cB;
        for (int t = 0; t < nt; t += 2) {
            const bool last = (t == nt - 2);
            const char* a1 = cA + (size_t)(t + 1) * kstep;
            const char* a2 = last ? nA : cA + (size_t)(t + 2) * kstep; const char* b2 = last ? nB : cB + (size_t)(t + 2) * kstep;
            const char* a3 = a2 + kstep; const char* b3 = b2 + kstep;
            if (last && has_next) S.a_ready(nxt);
            PG8_LDB(B0, 0, 0); PG8_SCHED; PG8_LDA(At, 0, 0); PG8_STAGE(PG8_SA(1, 1), a1 + hstep, voffA);
            PG8_WAIT_L(8); PG8_BAR; PG8_WAIT_L(0); PG8_MMA(0, 0, At, B0); PG8_BAR; PG8_SCHED;
            PG8_LDB(B1, 0, 1); PG8_STAGE(PG8_SB(0, 0), b2, voffB);
            PG8_BAR; PG8_WAIT_L(0); PG8_MMA(0, 1, At, B1); PG8_BAR;
            PG8_LDA(At, 0, 1); PG8_STAGE(PG8_SA(0, 0), a2, voffA);
            PG8_BAR; PG8_WAIT_L(0); PG8_MMA(1, 0, At, B0); PG8_BAR; PG8_SCHED;
            PG8_STAGE(PG8_SB(0, 1), b2 + hstep, voffB);
            PG8_WAIT_V(6); PG8_BAR; PG8_MMA(1, 1, At, B1); PG8_BAR;
            PG8_LDB(B0, 1, 0); PG8_SCHED; PG8_LDA(At, 1, 0); PG8_STAGE(PG8_SA(0, 1), a2 + hstep, voffA);
            PG8_WAIT_L(8); PG8_BAR; PG8_WAIT_L(0); PG8_MMA(0, 0, At, B0); PG8_BAR; PG8_SCHED;
            PG8_LDB(B1, 1, 1); PG8_STAGE(PG8_SB(1, 0), b3, voffB);
            PG8_BAR; PG8_WAIT_L(0); PG8_MMA(0, 1, At, B1); PG8_BAR;
            PG8_LDA(At, 1, 1); PG8_STAGE(PG8_SA(1, 0), a3, voffA);
            PG8_BAR; PG8_WAIT_L(0); PG8_MMA(1, 0, At, B0); PG8_BAR; PG8_SCHED;
            PG8_STAGE(PG8_SB(1, 1), b3 + hstep, voffB);
            PG8_WAIT_V(6); PG8_BAR; PG8_MMA(1, 1, At, B1); PG8_BAR;
        }
        if constexpr (!Epi::AFTER_DRAIN) { E(acc, cur, wr, wc, fr, fq); S.done(cur); }
        if (!has_next) break;
#pragma unroll
        for (int a = 0; a < 2; ++a)
#pragma unroll
            for (int b = 0; b < 2; ++b)
#pragma unroll
                for (int m = 0; m < 4; ++m)
#pragma unroll
                    for (int n = 0; n < 2; ++n) acc[a][b][m][n] = (f32x4){0.f, 0.f, 0.f, 0.f};
        cur = nxt; cA = nA; cB = nB; ++ui;
    }
    PG8_WAIT_V(0);
    if (wr == 0) PG8_BAR;
    PG8_BAR;
    if constexpr (Epi::AFTER_DRAIN) { E.fused(acc, cur, wr, wc, fr, fq, lds, wid, lane); S.done(cur); }
#undef PG8_SA
#undef PG8_SB
#undef PG8_STAGE
#undef PG8_LDA
#undef PG8_LDB
#undef PG8_MMA
#undef PG8_WAIT_V
#undef PG8_WAIT_L
#undef PG8_BAR
#undef PG8_SCHED
}
}

using namespace pg8;
typedef unsigned short u16;
typedef unsigned u32;
typedef u32 u32x2 __attribute__((ext_vector_type(2)));
typedef float f32x2v __attribute__((ext_vector_type(2)));

constexpr int ML = 32768, MCX = 1024, MT = 33792, FF = 2816;
constexpr int LDS_BYTES = 159744;
constexpr size_t OFF_U = 0, SZ_U = (size_t)MT * 1024 * 2;
constexpr size_t OFF_BIG = OFF_U + SZ_U, SZ_BIG = (size_t)MT * 7168 * 2;
constexpr size_t SZ_WGU = (size_t)5632 * 1024 * 2, SZ_WD = (size_t)1024 * 2816 * 2;
constexpr size_t OFF_WGU0 = OFF_BIG + SZ_BIG, OFF_WD0 = OFF_WGU0 + SZ_WGU, OFF_WGU1 = OFF_WD0 + SZ_WD, OFF_WD1 = OFF_WGU1 + SZ_WGU;
constexpr size_t OFF_WM1 = OFF_WD1 + SZ_WD, SZ_WM1 = (size_t)5376 * 1024 * 2, OFF_WM2 = OFF_WM1 + SZ_WM1, SZ_WM2 = (size_t)2048 * 1024 * 2;
constexpr size_t OFF_MOD = OFF_WM2 + SZ_WM2, SZ_MOD = (size_t)4 * 5 * 9216 * 4;
constexpr size_t OFF_HC = OFF_MOD + SZ_MOD, SZ_HC = (size_t)1024 * 1024 * 4;
constexpr size_t OFF_DT = OFF_HC + SZ_HC, SZ_DT = (size_t)MT * 64 * 4;
constexpr size_t OFF_HID2 = OFF_DT + SZ_DT, SZ_HID2 = (size_t)8192 * 64 * 4;
constexpr size_t OFF_HID2C = OFF_HID2 + SZ_HID2, SZ_HID2C = (size_t)256 * 64 * 4;
constexpr size_t OFF_CONST = OFF_HID2C + SZ_HID2C;
constexpr size_t OFF_BAR = OFF_CONST + 8192;
constexpr size_t OFF_TS = OFF_BAR + 16384;
constexpr size_t OFF_TAB = OFF_TS + 1024;
constexpr size_t WS_END = OFF_TAB + 1024;
constexpr size_t OFF_HID = OFF_BIG;
constexpr size_t OFF_Z = OFF_BIG, OFF_XBC = OFF_BIG + (size_t)MT * 2048 * 2, OFF_Y = OFF_BIG + (size_t)MT * 5120 * 2;
constexpr size_t OFF_HALO = OFF_U, OFF_CUM = OFF_U + (size_t)8 * 1024 * 1024, OFF_CBG = OFF_U + (size_t)20 * 1024 * 1024, OFF_YC1 = OFF_U + (size_t)56 * 1024 * 1024;
constexpr size_t OFF_POOLED = OFF_BIG;
constexpr size_t OFF_PT = OFF_BIG, OFF_YT = OFF_BIG + (size_t)3072 * MT * 2, OFF_KF = OFF_BIG + (size_t)4096 * MT * 2;
constexpr size_t OFF_ZS = OFF_KF + (size_t)256 * 4 * 8200 * 8;
constexpr int KF_STRIDE = 8200;
constexpr size_t OFF_PART = OFF_BIG;
constexpr size_t OFF_CPART = OFF_BIG + (size_t)200 * 1024 * 1024;

__device__ __forceinline__ int otid_(int wave) { int t = wave * 64 + (int)lane_id_now(); asm volatile("" : "+v"(t)); return t; }
#define otid() otid_(p.wave)
#define LDS_BARRIER() asm volatile("s_waitcnt lgkmcnt(0)\n\ts_barrier" ::: "memory")
struct KArgs { const float* in[33]; float* out; unsigned char* ws; };
struct Params { const float* const* in; float* out; unsigned char* ws; int wave; };

__device__ __forceinline__ u16 f2bf(float f) { u32 u = __float_as_uint(f); u += 0x7FFFu + ((u >> 16) & 1u); return (u16)(u >> 16); }
__device__ __forceinline__ float bf2f(u16 b) { return __uint_as_float(((u32)b) << 16); }
__device__ __forceinline__ u32 pack2(float lo, float hi) { return (u32)f2bf(lo) | ((u32)f2bf(hi) << 16); }
__device__ __forceinline__ u32 pack2hw(float lo, float hi) { u32 r; asm("v_cvt_pk_bf16_f32 %0, %1, %2" : "=v"(r) : "v"(lo), "v"(hi)); return r; }
__device__ __forceinline__ float bflo(u32 v) { return __uint_as_float(v << 16); }
__device__ __forceinline__ float bfhi(u32 v) { return __uint_as_float(v & 0xFFFF0000u); }
__device__ __forceinline__ u32x4 zero4() { u32 z = 0u; asm volatile("" : "+v"(z)); u32x4 r; r[0] = z; r[1] = z; r[2] = z; r[3] = z; return r; }
__device__ __forceinline__ float4 zerof4() { float z = 0.f; asm volatile("" : "+v"(z)); return make_float4(z, z, z, z); }
__device__ __forceinline__ float silu_f(float x) { return x * __builtin_amdgcn_rcpf(1.f + __expf(-x)); }
__device__ __forceinline__ float wave_sum(float v) {
#pragma unroll
    for (int o = 32; o >= 1; o >>= 1) v += __shfl_xor(v, o);
    return v;
}

struct EpiFFN1 {
    static constexpr bool PERM = true, AFTER_DRAIN = false;
    u16* H;
    __device__ __forceinline__ void operator()(const f32x4 (&acc)[2][2][4][2], const Unit& u, int wr, int wc, int fr, int fq) const {
        const int row0 = u.pm * BM + wr * 64 + fr, col0 = u.pn * 128 + wc * 32 + 8 * fq;
#pragma unroll
        for (int ai = 0; ai < 2; ++ai)
#pragma unroll
            for (int m = 0; m < 4; ++m) {
                const f32x4 g0 = acc[ai][0][m][0], g1 = acc[ai][0][m][1], u0 = acc[ai][1][m][0], u1 = acc[ai][1][m][1];
                u32x4 o;
                o[0] = pack2hw(silu_f(g0[0]) * u0[0], silu_f(g0[1]) * u0[1]); o[1] = pack2hw(silu_f(g0[2]) * u0[2], silu_f(g0[3]) * u0[3]);
                o[2] = pack2hw(silu_f(g1[0]) * u1[0], silu_f(g1[1]) * u1[1]); o[3] = pack2hw(silu_f(g1[2]) * u1[2], silu_f(g1[3]) * u1[3]);
                *(u32x4*)(H + (size_t)(row0 + ai * HALF + m * 16) * FF + col0) = o;
            }
    }
};
struct EpiResid {
    static constexpr bool PERM = false, AFTER_DRAIN = false;
    float* X; const float* Xsrc; const float* gate0; const float* bias; const float* cscale; float gmul; float pad_;
    __device__ __forceinline__ void operator()(const f32x4 (&acc)[2][2][4][2], const Unit& u, int wr, int wc, int fr, int fq) const {
        const int b = u.pm >> 5;
        const float* gate = gate0 + b * 9216;
        const int row0 = u.pm * BM + wr * 64 + fr, col0 = u.pn * BM + wc * 32 + 4 * fq;
#pragma unroll
        for (int bj = 0; bj < 2; ++bj)
#pragma unroll
            for (int n = 0; n < 2; ++n) { const int c = col0 + bj * HALF + n * 16;
                const f32x4 gv = *(const f32x4*)(gate + c) * gmul;
                const f32x4 bv = *(const f32x4*)(bias + c);
                const f32x4 sv = *(const f32x4*)(cscale + c);
#pragma unroll
                for (int ai = 0; ai < 2; ++ai)
#pragma unroll
                    for (int m = 0; m < 4; ++m) { const size_t o = (size_t)(row0 + ai * HALF + m * 16) * 1024 + c;
                        const f32x4 v = (acc[ai][bj][m][n] + bv) * sv;
                        *(f32x4*)(X + o) = *(const f32x4*)(Xsrc + o) + gv * v; } }
    }
};
struct EpiResidPart {
    static constexpr bool PERM = false, AFTER_DRAIN = false;
    float* P; const float* gate0; const float* bias; const float* cscale; float gmul; float pad_;
    __device__ __forceinline__ void operator()(const f32x4 (&acc)[2][2][4][2], const Unit& u, int wr, int wc, int fr, int fq) const {
        const float* gate = gate0 + 4 * 9216;
        const int row0 = (u.pm - 128) * BM + wr * 64 + fr, col0 = u.pn * BM + wc * 32 + 4 * fq;
#pragma unroll
        for (int bj = 0; bj < 2; ++bj)
#pragma unroll
            for (int n = 0; n < 2; ++n) { const int c = col0 + bj * HALF + n * 16;
                const f32x4 gv = *(const f32x4*)(gate + c) * gmul;
                const f32x4 bv = *(const f32x4*)(bias + c);
                const f32x4 sv = *(const f32x4*)(cscale + c);
#pragma unroll
                for (int ai = 0; ai < 2; ++ai)
#pragma unroll
                    for (int m = 0; m < 4; ++m)
                        *(f32x4*)(P + (size_t)(row0 + ai * HALF + m * 16) * 1024 + c) = gv * ((acc[ai][bj][m][n] + bv) * sv); }
    }
};
struct OneUnit {
    Unit u; bool has;
    __device__ __forceinline__ bool next(int i, Unit& o) const { if (i == 0 && has) { o = u; return true; } return false; }
    __device__ __forceinline__ void a_ready(const Unit&) const {}
    __device__ __forceinline__ void done(const Unit&) const {}
};
struct EpiSSDin {
    static constexpr bool PERM = true, AFTER_DRAIN = false;
    u16* Z; u16* XBC; float* DT;
    __device__ __forceinline__ void operator()(const f32x4 (&acc)[2][2][4][2], const Unit& u, int wr, int wc, int fr, int fq) const {
        const int row0 = u.pm * BM + wr * 64 + fr, cw = wc * 32 + 8 * fq;
        if (u.pn < 20) {
            u16* base; int ld;
            if (u.pn < 8) { base = Z + u.pn * 256; ld = 2048; } else { base = XBC + (u.pn - 8) * 256; ld = 3072; }
#pragma unroll
            for (int ai = 0; ai < 2; ++ai)
#pragma unroll
                for (int m = 0; m < 4; ++m) { u16* rp = base + (size_t)(row0 + ai * HALF + m * 16) * ld + cw;
#pragma unroll
                    for (int bj = 0; bj < 2; ++bj) { const f32x4 v0 = acc[ai][bj][m][0], v1 = acc[ai][bj][m][1]; u32x4 o;
                        o[0] = pack2(v0[0], v0[1]); o[1] = pack2(v0[2], v0[3]); o[2] = pack2(v1[0], v1[1]); o[3] = pack2(v1[2], v1[3]);
                        *(u32x4*)(rp + bj * HALF) = o; } }
        } else if (wc < 2) {
#pragma unroll
            for (int ai = 0; ai < 2; ++ai)
#pragma unroll
                for (int m = 0; m < 4; ++m) { float* rp = DT + (size_t)(row0 + ai * HALF + m * 16) * 64 + cw;
                    *(f32x4*)(rp) = acc[ai][0][m][0]; *(f32x4*)(rp + 4) = acc[ai][0][m][1]; }
        }
    }
};
struct EpiBf16T {
    static constexpr bool PERM = true, AFTER_DRAIN = false;
    u16* O; int ldc;
    __device__ __forceinline__ void operator()(const f32x4 (&acc)[2][2][4][2], const Unit& u, int wr, int wc, int fr, int fq) const {
        const int row0 = u.pm * BM + wr * 64 + fr, col0 = u.pn * BM + wc * 32 + 8 * fq;
#pragma unroll
        for (int ai = 0; ai < 2; ++ai)
#pragma unroll
            for (int m = 0; m < 4; ++m) { u16* rp = O + (size_t)(row0 + ai * HALF + m * 16) * ldc + col0;
#pragma unroll
                for (int bj = 0; bj < 2; ++bj) { const f32x4 v0 = acc[ai][bj][m][0], v1 = acc[ai][bj][m][1]; u32x4 o;
                    o[0] = pack2(v0[0], v0[1]); o[1] = pack2(v0[2], v0[3]); o[2] = pack2(v1[0], v1[1]); o[3] = pack2(v1[2], v1[3]);
                    *(u32x4*)(rp + bj * HALF) = o; } }
    }
};
template <class Epi> __device__ __forceinline__ void run_gemm(int wave_, unsigned char* shm, const u16* A, const u16* Bt, int M, int N, int K, const Epi E) {
    StaticOrder S; S.init(M, N, (int)gridDim.x, (int)blockIdx.x);
    Gemm g; g.A = A; g.Bt = Bt; g.M = M; g.N = N; g.K = K; g.ld = K; g.wave = wave_;
    gemm_phase<Epi, StaticOrder>((PG8_LAS unsigned char*)shm, g, S, E);
}

__device__ __forceinline__ void phase_setup(const KArgs& p, unsigned char* shm, int wave_) {
    const int tid = otid_(wave_);
    if (blockIdx.x == 0 && tid < 33) ((const float**)(p.ws + OFF_TAB))[tid] = p.in[tid];
    float* fl = (float*)shm;
    if (blockIdx.x == 0) { float* cz = (float*)(p.ws + OFF_CONST); for (int i = tid; i < 2048; i += 512) cz[i] = i < 1024 ? 0.f : 1.f; }
    {
        const float* cvec = p.in[1]; const float* cctx = p.in[3]; const float* aw = p.in[4];
        float* part = (float*)(p.ws + OFF_PART);
        for (int it = blockIdx.x; it < 576; it += gridDim.x) {
            const int layer = it / 144, rem = it % 144, cc = rem >> 3, kc = rem & 7;
            __syncthreads();
            for (int i = tid; i < 640; i += 512) { const int r = i >> 7, k = i & 127; const float v = r < 4 ? cvec[r * 1024 + kc * 128 + k] : cctx[kc * 128 + k]; fl[i] = silu_f(v); }
            __syncthreads();
            const int col = cc * 512 + tid;
            float a0 = 0.f, a1 = 0.f, a2 = 0.f, a3 = 0.f, a4 = 0.f;
            const float* wp = aw + ((size_t)layer * 1024 + kc * 128) * 9216 + col;
#pragma unroll 8
            for (int k = 0; k < 128; ++k) { const float w = wp[(size_t)k * 9216]; a0 += fl[k] * w; a1 += fl[128 + k] * w; a2 += fl[256 + k] * w; a3 += fl[384 + k] * w; a4 += fl[512 + k] * w; }
            float* po = part + ((size_t)(kc * 4 + layer) * 5) * 9216 + col;
            po[0] = a0; po[9216] = a1; po[2 * 9216] = a2; po[3 * 9216] = a3; po[4 * 9216] = a4;
        }
    }
    {
        const float* fw1 = p.in[24]; const float* fb1 = p.in[25]; const float* fw2 = p.in[26]; const float* fb2 = p.in[27]; const float* fq = p.in[29];
        float* zs = fl + 1024; float* h1s = fl + 1024 + 8 * 36;
        const int pl = tid >> 6, jx = tid & 63;
        for (int grp = blockIdx.x; grp < 1056; grp += gridDim.x) {
            int L, pos; float* outp;
            if (grp < 1024) { L = 8192; pos = grp * 8 + pl; outp = (float*)(p.ws + OFF_HID2) + (size_t)pos * 64; }
            else { L = 256; pos = (grp - 1024) * 8 + pl; outp = (float*)(p.ws + OFF_HID2C) + (size_t)pos * 64; }
            __syncthreads();
            if (jx < 33) {
                float zv;
                if (jx == 0) zv = (float)pos / (float)(L - 1);
                else { const int k = (jx - 1) & 15; const float f = 1e-4f + (float)k * ((15.0f - 1e-4f) / 15.0f);
                    const float wpos = (6.283185307179586f * (float)pos) / (float)L; const float ang = wpos * f;
                    zv = jx <= 16 ? cosf(ang) : -sinf(ang); }
                zs[pl * 36 + jx] = zv;
            }
            __syncthreads();
            float a = fb1[jx];
            for (int i = 0; i < 33; ++i) a += zs[pl * 36 + i] * fw1[i * 64 + jx];
            h1s[pl * 64 + jx] = sinf(fq[jx] * a);
            __syncthreads();
            float a2 = fb2[jx];
            for (int i = 0; i < 64; ++i) a2 += h1s[pl * 64 + i] * fw2[i * 64 + jx];
            outp[jx] = sinf(fq[64 + jx] * a2);
        }
    }
}
__device__ __forceinline__ void phase_modreduce(const Params& p) {
    const float* part = (const float*)(p.ws + OFF_PART); const float* ab = p.in[5]; float* mod = (float*)(p.ws + OFF_MOD);
    for (int idx = blockIdx.x * 512 + otid(); idx < 4 * 5 * 9216; idx += gridDim.x * 512) {
        const int layer = idx / 46080, col = idx % 9216;
        float s = ab[layer * 9216 + col];
#pragma unroll
        for (int kc = 0; kc < 8; ++kc) s += part[(size_t)kc * 184320 + idx];
        mod[idx] = s;
    }
}

__device__ __forceinline__ void convert_job(const Params& p, const float* src, int K, int N, int lds_, u16* dst, int ldd, int nmul, int noff, int koff, unsigned char* shm) {
    float* tile = (float*)shm;
    const int tid = otid(), tk = K >> 6, tn = N >> 6, nt = tk * tn;
    float v[8], nv[8];
    int t = blockIdx.x;
    if (t < nt) { const int k0 = (t / tn) << 6, n0 = (t % tn) << 6;
#pragma unroll
        for (int r = 0; r < 8; ++r) v[r] = src[(size_t)(k0 + (tid >> 6) + 8 * r) * lds_ + n0 + (tid & 63)]; }
    for (; t < nt; t += gridDim.x) {
        const int k0 = (t / tn) << 6, n0 = (t % tn) << 6;
        const int t2 = t + (int)gridDim.x;
        if (t2 < nt) { const int k1 = (t2 / tn) << 6, n1 = (t2 % tn) << 6;
#pragma unroll
            for (int r = 0; r < 8; ++r) nv[r] = src[(size_t)(k1 + (tid >> 6) + 8 * r) * lds_ + n1 + (tid & 63)]; }
        LDS_BARRIER();
#pragma unroll
        for (int r = 0; r < 8; ++r) tile[((tid >> 6) + 8 * r) * 65 + (tid & 63)] = v[r];
        LDS_BARRIER();
#pragma unroll
        for (int r = 0; r < 4; ++r) { const int jn = (tid >> 5) + 16 * r, ik = (tid & 31) * 2; const int n = n0 + jn;
            const int nd = (n >> 7) * nmul + noff + (n & 127);
            *(u32*)(dst + (size_t)nd * ldd + koff + k0 + ik) = pack2(tile[ik * 65 + jn], tile[(ik + 1) * 65 + jn]); }
#pragma unroll
        for (int r = 0; r < 8; ++r) v[r] = nv[r];
    }
    __syncthreads();
}
__device__ __forceinline__ void convert_layer(const Params& p, int layer, unsigned char* shm) {
    const int kind = layer % 3, j = layer / 3;
    u16* wm1 = (u16*)(p.ws + OFF_WM1); u16* wm2 = (u16*)(p.ws + OFF_WM2);
    if (kind == 1) {
        for (int t = blockIdx.x; t < 192; t += gridDim.x) {
            const int ob = t >> 4, piece = t & 15; const int gr = ob / 3, gcr = ob % 3; const int gc = gcr + (gcr >= gr ? 1 : 0);
            const int tid = otid(); const int r = piece * 16 + (tid >> 5), c8 = (tid & 31) * 8;
            *(u32x4*)(wm1 + (size_t)(gr * 256 + r) * 1024 + gc * 256 + c8) = zero4();
        }
    }
    const int njobs = kind == 1 ? 10 : 8;
#pragma unroll 1
    for (int jb = 0; jb < njobs; ++jb) {
        const float* src; int K, N, ld, ldd, nmul = 128, noff = 0, koff = 0; u16* dst;
        if (jb < 6) { const int f = jb / 3, w = jb - 3 * f; const size_t wo = (size_t)(layer * 2 + f) * 1024 * FF;
            u16* wgu = (u16*)(p.ws + (f ? OFF_WGU1 : OFF_WGU0)); u16* wd = (u16*)(p.ws + (f ? OFF_WD1 : OFF_WD0));
            if (w < 2) { src = p.in[7 + w] + wo; K = 1024; N = FF; ld = FF; dst = wgu; ldd = 1024; nmul = 256; noff = w * 128; }
            else { src = p.in[9] + wo; K = FF; N = 1024; ld = 1024; dst = wd; ldd = FF; }
        } else if (kind == 0) {
            if (jb == 6) { src = p.in[10] + (size_t)j * 1024 * 5184; K = 1024; N = 5184; ld = 5184; dst = wm1; ldd = 1024; }
            else { src = p.in[17] + (size_t)j * 2048 * 1024; K = 2048; N = 1024; ld = 1024; dst = wm2; ldd = 2048; }
        } else if (kind == 1) { const int g = jb - 6;
            src = p.in[18] + (size_t)g * 65536; K = 256; N = 256; ld = 256; dst = wm1; ldd = 1024; noff = g * 256; koff = g * 256;
        } else {
            if (jb == 6) { src = p.in[21]; K = 1024; N = 3072; ld = 3072; dst = wm1; ldd = 1024; }
            else { src = p.in[31]; K = 1024; N = 1024; ld = 1024; dst = wm2; ldd = 1024; }
        }
        convert_job(p, src, K, N, ld, dst, ldd, nmul, noff, koff, shm);
    }
}

__device__ __forceinline__ void phase_modulate(const Params& p, int layer, int which, int nslice, bool first) {
    const int lane = otid() & 63, gw = blockIdx.x * 8 + (otid() >> 6), nw = gridDim.x * 8;
    const float* g = p.in[6] + (size_t)(layer * 3 + which) * 1024;
    const float* mod = (const float*)(p.ws + OFF_MOD) + (size_t)layer * 5 * 9216;
    const float* Hc = first ? p.in[2] : (const float*)(p.ws + OFF_HC); const float* Xl = first ? p.in[0] : (const float*)p.out; u16* U = (u16*)(p.ws + OFF_U);
    const int r0 = gw, r1 = MT;
    float4 A[4], H[4], v[4], nv[4]; int cb = -1;
    { const float* xr = r0 < ML ? Xl + (size_t)r0 * 1024 : Hc + (size_t)(r0 - ML) * 1024;
#pragma unroll
      for (int k = 0; k < 4; ++k) v[k] = *(const float4*)(xr + k * 256 + lane * 4); }
    for (int row = r0; row < r1; row += nw) {
        if (row + nw < r1) { const int rn = row + nw; const float* xr = rn < ML ? Xl + (size_t)rn * 1024 : Hc + (size_t)(rn - ML) * 1024;
#pragma unroll
            for (int k = 0; k < 4; ++k) nv[k] = *(const float4*)(xr + k * 256 + lane * 4); }
        const int b = row < ML ? (row >> 13) : 4;
        if (b != cb) { cb = b; const float* sh = mod + (size_t)b * 9216 + (3 * which) * 1024; const float* sc = sh + 1024;
#pragma unroll
            for (int k = 0; k < 4; ++k) { const int c = k * 256 + lane * 4; const float4 g4 = *(const float4*)(g + c), s4 = *(const float4*)(sc + c); H[k] = *(const float4*)(sh + c);
                A[k] = make_float4(g4.x * (1.f + s4.x), g4.y * (1.f + s4.y), g4.z * (1.f + s4.z), g4.w * (1.f + s4.w)); } }
        if (row >= ML && (nslice > 0 || first)) {
            const float* pp = (const float*)(p.ws + OFF_CPART) + (size_t)(row - ML) * 1024 + lane * 4;
#pragma unroll 1
            for (int s0 = 0; s0 < nslice; s0 += 4) {
                float4 q[4][4];
#pragma unroll
                for (int jq = 0; jq < 4; ++jq) { const int sl = min(s0 + jq, nslice - 1);
#pragma unroll
                    for (int k = 0; k < 4; ++k) q[jq][k] = *(const float4*)(pp + (size_t)sl * 1024 * 1024 + k * 256); }
#pragma unroll
                for (int jq = 0; jq < 4; ++jq) { const float wq = (s0 + jq < nslice) ? 1.f : 0.f;
#pragma unroll
                    for (int k = 0; k < 4; ++k) { v[k].x += wq * q[jq][k].x; v[k].y += wq * q[jq][k].y; v[k].z += wq * q[jq][k].z; v[k].w += wq * q[jq][k].w; } }
            }
            float* xw = (float*)(p.ws + OFF_HC) + (size_t)(row - ML) * 1024;
#pragma unroll
            for (int k = 0; k < 4; ++k) *(float4*)(xw + k * 256 + lane * 4) = v[k];
        }
        float ss = 0.f;
#pragma unroll
        for (int k = 0; k < 4; ++k) ss += v[k].x * v[k].x + v[k].y * v[k].y + v[k].z * v[k].z + v[k].w * v[k].w;
        ss = wave_sum(ss);
        const float rstd = rsqrtf(ss * (1.f / 1024.f) + 1e-6f);
#pragma unroll
        for (int k = 0; k < 4; ++k) { const int c = k * 256 + lane * 4;
            u32x2 o;
            o[0] = pack2(v[k].x * rstd * A[k].x + H[k].x, v[k].y * rstd * A[k].y + H[k].y);
            o[1] = pack2(v[k].z * rstd * A[k].z + H[k].z, v[k].w * rstd * A[k].w + H[k].w);
            *(u32x2*)(U + (size_t)row * 1024 + c) = o; }
#pragma unroll
        for (int k = 0; k < 4; ++k) v[k] = nv[k];
    }
}
__device__ __forceinline__ void phase_final(const Params& p) {
    const int lane = otid() & 63, gw = blockIdx.x * 8 + (otid() >> 6), nw = gridDim.x * 8;
    const float* g = p.in[32];
    for (int row = gw; row < ML; row += nw) {
        float* xr = p.out + (size_t)row * 1024;
        float4 v[4]; float ss = 0.f;
#pragma unroll
        for (int k = 0; k < 4; ++k) { v[k] = *(const float4*)(xr + k * 256 + lane * 4); ss += v[k].x * v[k].x + v[k].y * v[k].y + v[k].z * v[k].z + v[k].w * v[k].w; }
        ss = wave_sum(ss);
        const float rstd = rsqrtf(ss * (1.f / 1024.f) + 1e-6f);
#pragma unroll
        for (int k = 0; k < 4; ++k) { const int c = k * 256 + lane * 4; const float4 g4 = *(const float4*)(g + c);
            float4 o; o.x = v[k].x * rstd * g4.x; o.y = v[k].y * rstd * g4.y; o.z = v[k].z * rstd * g4.z; o.w = v[k].w * rstd * g4.w;
            *(float4*)(xr + c) = o; }
    }
}

#define XB_TMO      128
#define XB_XCNT(j)  (256  + 64 * (j))
#define XB_XSUB(j)  (1280 + 64 * (j))
#define XB_XGEN(j)  (2304 + 64 * (j))
#define XB_TOP      3328
#define XB_TOPGEN   3392
#define XCD_BAR_WORDS 3456
#define XB_SPIN_CAP (1u << 18)

__device__ __forceinline__ unsigned xb_ld(unsigned* p)              { return __hip_atomic_load(p, __ATOMIC_RELAXED, __HIP_MEMORY_SCOPE_AGENT); }
__device__ __forceinline__ unsigned xb_add(unsigned* p, unsigned v) { return __hip_atomic_fetch_add(p, v, __ATOMIC_RELAXED, __HIP_MEMORY_SCOPE_AGENT); }
__device__ __forceinline__ unsigned xb_xcc_id() { return (unsigned)__builtin_amdgcn_s_getreg((3 << 11) | 20) & 0xFu; }
#define XB_SPIN(cond, bar) do { unsigned _sp = 0; while (cond) { __builtin_amdgcn_s_sleep(1); \
    if ((++_sp & 255u) == 0u) { if (xb_ld(&(bar)[XB_TMO])) break; if (_sp > XB_SPIN_CAP) { atomicAdd(&(bar)[XB_TMO], 1u); break; } } } } while (0)

struct XcdBarrier {
    unsigned* bar; unsigned x; int wave;
    volatile PG8_LAS unsigned* st;
};

__device__ __forceinline__ XcdBarrier xcd_barrier_post(unsigned* bar, volatile PG8_LAS unsigned* st) {
    XcdBarrier b; b.bar = bar; b.x = xb_xcc_id(); b.st = st;
    if (threadIdx.x == 0) (void)xb_add(&bar[XB_XCNT(b.x)], 1u);
    return b;
}
__device__ __forceinline__ void xcd_barrier_complete(unsigned* bar, unsigned x, unsigned& nloc, unsigned& nx) {
    const unsigned G = gridDim.x * gridDim.y * gridDim.z;
    unsigned sum, cnt, mine, sp = 0u;
    for (;;) {
        sum = 0u; cnt = 0u; mine = 0u;
#pragma unroll
        for (unsigned j = 0; j < 16; ++j) { const unsigned c = xb_ld(&bar[XB_XCNT(j)]); sum += c; cnt += (c > 0u) ? 1u : 0u; mine = (j == x) ? c : mine; }
        if (sum == G) break;
        __builtin_amdgcn_s_sleep(1);
        if ((++sp & 255u) == 0u) { if (xb_ld(&bar[XB_TMO])) break; if (sp > XB_SPIN_CAP) { atomicAdd(&bar[XB_TMO], 1u); break; } }
    }
    nloc = mine > 0u ? mine : 1u; nx = cnt > 0u ? cnt : 1u;
}

__device__ __forceinline__ void xcd_barrier(const XcdBarrier& b) {
    asm volatile("s_waitcnt vmcnt(0)" ::: "memory");
    __syncthreads();
    if (b.wave == 0 && lane_id_now() == 0u) {
        unsigned* bar = b.bar;
        __builtin_amdgcn_s_waitcnt(0);
        unsigned nloc = b.st[0], nx = b.st[1];
        if (nloc == 0u) { xcd_barrier_complete(bar, b.x, nloc, nx); b.st[0] = nloc; b.st[1] = nx; }
        const unsigned old = xb_add(&bar[XB_XSUB(b.x)], 1u);
        const unsigned gen = old / nloc;
        if (old + 1u == (gen + 1u) * nloc) {
            __builtin_amdgcn_fence(__ATOMIC_RELEASE, "agent");
            asm volatile("s_waitcnt vmcnt(0)" ::: "memory");
            const unsigned og = xb_add(&bar[XB_TOP], 1u);
            const unsigned tg = og / nx;
            if (og + 1u == (tg + 1u) * nx) xb_add(&bar[XB_TOPGEN], 1u);
            else XB_SPIN(xb_ld(&bar[XB_TOPGEN]) == tg, bar);
            __builtin_amdgcn_fence(__ATOMIC_ACQUIRE, "agent");
            xb_add(&bar[XB_XGEN(b.x)], 1u);
            asm volatile("s_waitcnt vmcnt(0)" ::: "memory");
        } else {
            XB_SPIN(xb_ld(&bar[XB_XGEN(b.x)]) == gen, bar);
            __builtin_amdgcn_fence(__ATOMIC_ACQUIRE, "agent");
            asm volatile("s_waitcnt vmcnt(0)" ::: "memory");
        }
    }
    __syncthreads();
}


__device__ __forceinline__ int swz(int row, int col) { return row * 256 + ((((col >> 3) ^ (row & 15))) << 4) + ((col & 7) << 1); }
__device__ __forceinline__ void unpack8(const u32x4 v, float (&f)[8]) {
    f[0] = bflo(v[0]); f[1] = bfhi(v[0]); f[2] = bflo(v[1]); f[3] = bfhi(v[1]); f[4] = bflo(v[2]); f[5] = bfhi(v[2]); f[6] = bflo(v[3]); f[7] = bfhi(v[3]);
}
__device__ __forceinline__ void phase_ssd_prep1(const Params& p, int j) {
    const int tid = otid();
    const u16* XBC = (const u16*)(p.ws + OFF_XBC); u16* HALO = (u16*)(p.ws + OFF_HALO);
    for (int idx = blockIdx.x * 512 + tid; idx < 264 * 4 * 384; idx += gridDim.x * 512) {
        const int q = idx / 1536, rem = idx - q * 1536, hr = rem / 384, v = rem - hr * 384;
        const int row = q * 128 + (hr < 2 ? hr - 2 : 126 + hr);
        int seg_lo, seg_hi;
        if (q < 256) { seg_lo = (q >> 6) * 8192; seg_hi = seg_lo + 8192; } else { seg_lo = ML + ((q - 256) >> 1) * 256; seg_hi = seg_lo + 256; }
        u32x4 val = zero4();
        if (row >= seg_lo && row < seg_hi) val = *(const u32x4*)(XBC + (size_t)row * 3072 + v * 8);
        *(u32x4*)(HALO + (size_t)(q * 4 + hr) * 3072 + v * 8) = val;
    }
    float* DT = (float*)(p.ws + OFF_DT); float* CUM = (float*)(p.ws + OFF_CUM);
    for (int gid = blockIdx.x * 512 + tid; gid < 264 * 64; gid += gridDim.x * 512) {
        const int q = gid >> 6, col = gid & 63, d = col >> 5;
        const float Aneg = -__expf(p.in[13][j * 64 + col]), dtb = p.in[14][j * 64 + col];
        float s = 0.f;
#pragma unroll 1
        for (int i0 = 0; i0 < 128; i0 += 16) {
            float raw[16];
#pragma unroll
            for (int k = 0; k < 16; ++k) { const int l = d == 0 ? i0 + k : 127 - i0 - k; raw[k] = DT[(size_t)(q * 128 + l) * 64 + col]; }
#pragma unroll
            for (int k = 0; k < 16; ++k) { const int l = d == 0 ? i0 + k : 127 - i0 - k; const size_t o = (size_t)(q * 128 + l) * 64 + col;
                const float r = raw[k] + dtb; const float dt = r > 20.f ? r : log1pf(__expf(r));
                s += dt * Aneg; DT[o] = dt; CUM[(size_t)(q * 64 + col) * 128 + l] = s; }
        }
    }
}
__device__ __forceinline__ void phase_ssd_prep2(const Params& p, int j) {
    const int tid = otid(), co = tid & 31, rg = tid >> 5;
    u16* XBC = (u16*)(p.ws + OFF_XBC); const u16* HALO = (const u16*)(p.ws + OFF_HALO);
    const float* conv_w = p.in[11] + (size_t)j * 5 * 3072; const float* conv_b = p.in[12] + (size_t)j * 3072;
#define PREP2_LOAD(dst, it_) do { const int q_ = (it_) / 12, cs_ = (it_) - q_ * 12; const int col_ = cs_ * 256 + co * 8; \
        _Pragma("unroll") for (int i = 0; i < 12; ++i) { const int l = rg * 8 - 2 + i;     \
            const u16* src = l < 0 ? HALO + (size_t)(q_ * 4 + 2 + l) * 3072 : (l >= 128 ? HALO + (size_t)(q_ * 4 + l - 126) * 3072 : XBC + (size_t)(q_ * 128 + l) * 3072); \
            dst[i] = *(const u32x4*)(src + col_); } } while (0)
    u32x4 in[12], nin[12];
    if ((int)blockIdx.x < 264 * 12) PREP2_LOAD(in, (int)blockIdx.x);
    for (int item = blockIdx.x; item < 264 * 12; item += gridDim.x) {
        const int q = item / 12, cs = item - q * 12; const int col = cs * 256 + co * 8;
        asm volatile("s_waitcnt vmcnt(0)" ::: "memory");
        __syncthreads();
        if (item + (int)gridDim.x < 264 * 12) PREP2_LOAD(nin, item + (int)gridDim.x);
        u32 pk[8][4];
#pragma unroll
        for (int c2 = 0; c2 < 4; ++c2) {
            { const int c = col + 2 * c2; const float w0 = conv_w[c], w1 = conv_w[3072 + c], w2 = conv_w[6144 + c], w3 = conv_w[9216 + c], w4 = conv_w[12288 + c], bb = conv_b[c];
#pragma unroll
              for (int r = 0; r < 8; ++r) pk[r][c2] = (u32)f2bf(silu_f(bb + w0 * bflo(in[r][c2]) + w1 * bflo(in[r + 1][c2]) + w2 * bflo(in[r + 2][c2]) + w3 * bflo(in[r + 3][c2]) + w4 * bflo(in[r + 4][c2]))); }
            { const int c = col + 2 * c2 + 1; const float w0 = conv_w[c], w1 = conv_w[3072 + c], w2 = conv_w[6144 + c], w3 = conv_w[9216 + c], w4 = conv_w[12288 + c], bb = conv_b[c];
#pragma unroll
              for (int r = 0; r < 8; ++r) pk[r][c2] |= (u32)f2bf(silu_f(bb + w0 * bfhi(in[r][c2]) + w1 * bfhi(in[r + 1][c2]) + w2 * bfhi(in[r + 2][c2]) + w3 * bfhi(in[r + 3][c2]) + w4 * bfhi(in[r + 4][c2]))) << 16; }
        }
#pragma unroll
        for (int r = 0; r < 8; ++r) { u32x4 pv; pv[0] = pk[r][0]; pv[1] = pk[r][1]; pv[2] = pk[r][2]; pv[3] = pk[r][3];
            *(u32x4*)(XBC + (size_t)(q * 128 + rg * 8 + r) * 3072 + col) = pv; }
#pragma unroll
        for (int i = 0; i < 12; ++i) in[i] = nin[i];
    }
#undef PREP2_LOAD
}
__device__ __forceinline__ void phase_ssd_cb(const Params& p, unsigned char* lds) {
    const int tid = otid(), wave = __builtin_amdgcn_readfirstlane(tid >> 6), lane = tid & 63, fr = lane & 15, fq = lane >> 4;
    unsigned char* Cs = lds; unsigned char* Bs = lds + 32768;
    const u16* XBC = (const u16*)(p.ws + OFF_XBC); u16* CBG = (u16*)(p.ws + OFF_CBG);
    const int co = tid & 15, rg = tid >> 4;
    for (int item = blockIdx.x; item < 264 * 4; item += gridDim.x) {
        const int q = item >> 2, g = item & 3;
        u32x4 cv[4], bv[4];
#pragma unroll
        for (int r = 0; r < 4; ++r) { const size_t ro = (size_t)(q * 128 + rg * 4 + r) * 3072;
            cv[r] = *(const u32x4*)(XBC + ro + 2560 + g * 128 + co * 8); bv[r] = *(const u32x4*)(XBC + ro + 2048 + g * 128 + co * 8); }
        __syncthreads();
#pragma unroll
        for (int r = 0; r < 4; ++r) { *(u32x4*)(Cs + swz(rg * 4 + r, co * 8)) = cv[r]; *(u32x4*)(Bs + swz(rg * 4 + r, co * 8)) = bv[r]; }
        __syncthreads();
        bf16x8 afrag[4];
#pragma unroll
        for (int kk = 0; kk < 4; ++kk) afrag[kk] = *(const bf16x8*)(Cs + swz(wave * 16 + fr, kk * 32 + fq * 8));
#pragma unroll
        for (int st = 0; st < 8; ++st) {
            f32x4 acc = (f32x4){0.f, 0.f, 0.f, 0.f};
#pragma unroll
            for (int kk = 0; kk < 4; ++kk) { const bf16x8 bfrag = *(const bf16x8*)(Bs + swz(st * 16 + fr, kk * 32 + fq * 8)); acc = __builtin_amdgcn_mfma_f32_16x16x32_bf16(bfrag, afrag[kk], acc, 0, 0, 0); }
            u32x2 o; o[0] = pack2(acc[0], acc[1]); o[1] = pack2(acc[2], acc[3]);
            *(u32x2*)(CBG + (size_t)item * 16384 + (wave * 16 + fr) * 128 + st * 16 + fq * 4) = o;
        }
    }
}
__device__ __forceinline__ void phase_ssd_scan(const Params& p, int j, unsigned char* lds) {
    const int tid0 = otid(), wave = __builtin_amdgcn_readfirstlane(tid0 >> 6);
    unsigned char* Cs = lds; unsigned char* BTs = lds + 32768; unsigned char* Gs = lds + 65536;
    unsigned char* XTs = lds + 98304; unsigned char* Hs = lds + 114688;
    float* cum = (float*)(lds + 131072); float* dtv = cum + 128;
    const u16* XBC = (const u16*)(p.ws + OFF_XBC); const float* DT = (const float*)(p.ws + OFF_DT); const float* CUM = (const float*)(p.ws + OFF_CUM);
    const u16* CBG = (const u16*)(p.ws + OFF_CBG); u16* Y = (u16*)(p.ws + OFF_Y); u16* YC1 = (u16*)(p.ws + OFF_YC1);
    {
        const int it0 = (int)blockIdx.x;
        const int gid = (it0 & 7) + 8 * (it0 >> 6), member = (it0 >> 3) & 7;
        const int d = gid & 1, b = gid >> 3, g = (gid >> 1) & 3, h = g * 8 + member;
        const int xc0 = h * 64, bc0 = 2048 + g * 128, cc0 = 2560 + g * 128, col = d * 32 + h;
        const float Dh = p.in[15][j * 32 + h];
        f32x4 hreg[4];
#pragma unroll
        for (int pt = 0; pt < 4; ++pt) hreg[pt] = (f32x4){0.f, 0.f, 0.f, 0.f};
        __syncthreads();
        *(u32x4*)(Hs + tid0 * 32) = zero4(); *(u32x4*)(Hs + tid0 * 32 + 16) = zero4();
        u32x4 Cr[4], Br[4], Gr[4], Xr[2]; f32x4 cumr, cums0, cums1; float dtl[2], cum128 = 0.f, dt128 = 0.f, tot; u32x2 yold[4];
#define SSD_ROW0(ci) ((ci) < 2 ? ML + b * 256 + (d == 0 ? (ci) : 1 - (ci)) * 128 : b * 8192 + (d == 0 ? (ci) - 2 : 65 - (ci)) * 128)
#define SSD_LOAD(ci, T) do { const int r0_ = SSD_ROW0(ci); const int co_ = (T) & 15, rg_ = (T) >> 4, xo_ = (T) & 7, l_ = (T) >> 3; \
            const float* cb_ = CUM + (size_t)((r0_ >> 7) * 64 + col) * 128; const u16* gb_ = CBG + (size_t)((r0_ >> 7) * 4 + g) * 16384; \
            _Pragma("unroll") for (int r = 0; r < 4; ++r) { const size_t ro_ = (size_t)(r0_ + rg_ * 4 + r); \
                Cr[r] = *(const u32x4*)(XBC + ro_ * 3072 + cc0 + co_ * 8); Br[r] = *(const u32x4*)(XBC + ro_ * 3072 + bc0 + co_ * 8); \
                Gr[r] = *(const u32x4*)(gb_ + (rg_ * 4 + r) * 128 + co_ * 8); } \
            cumr = *(const f32x4*)(cb_ + rg_ * 4); cums0 = *(const f32x4*)(cb_ + co_ * 8); cums1 = *(const f32x4*)(cb_ + co_ * 8 + 4); \
            _Pragma("unroll") for (int i = 0; i < 2; ++i) { Xr[i] = *(const u32x4*)(XBC + (size_t)(r0_ + l_ + 64 * i) * 3072 + xc0 + xo_ * 8); dtl[i] = DT[(size_t)(r0_ + l_ + 64 * i) * 64 + col]; } \
            tot = cb_[d == 0 ? 127 : 0]; \
            if ((T) < 128) { cum128 = cb_[(T)]; dt128 = DT[(size_t)(r0_ + (T)) * 64 + col]; } \
            } while (0)
#define SSD_LOADY(ci, T) do { if ((ci) >= 34) { const int r0_ = SSD_ROW0(ci); const int fr_ = (T) & 15, fq_ = ((T) & 63) >> 4; \
                _Pragma("unroll") for (int pt = 0; pt < 4; ++pt) yold[pt] = *(const u32x2*)(Y + (size_t)(r0_ + wave * 16 + fr_) * 2048 + xc0 + pt * 16 + fq_ * 4); } } while (0)
        SSD_LOAD(0, tid0);
        for (int ci = 0; ci < 66; ++ci) {
            int tid = tid0; asm volatile("" : "+v"(tid));
            if (ci == 34) {
                XcdBarrier xb_; xb_.bar = (unsigned*)(p.ws + OFF_BAR); xb_.x = xb_xcc_id(); xb_.wave = p.wave; xb_.st = (volatile PG8_LAS unsigned*)((PG8_LAS unsigned char*)lds + (LDS_BYTES - 16));
                xcd_barrier(xb_);
                SSD_LOAD(34, tid); SSD_LOADY(34, tid);
            }
            const int lane = tid & 63, fr = lane & 15, fq = lane >> 4;
            const int row0 = SSD_ROW0(ci);
            const float total = tot;
            {
                const int co = tid & 15, rg = tid >> 4;
                float wg[4];
#pragma unroll
                for (int r = 0; r < 4; ++r) { *(u32x4*)(Cs + swz(rg * 4 + r, co * 8)) = Cr[r]; wg[r] = __expf(total - cumr[r]); }
#pragma unroll
                for (int c2 = 0; c2 < 4; ++c2) { u32x2 q0, q1;
                    q0[0] = pack2hw(bflo(Br[0][c2]) * wg[0], bflo(Br[1][c2]) * wg[1]); q0[1] = pack2hw(bflo(Br[2][c2]) * wg[2], bflo(Br[3][c2]) * wg[3]);
                    q1[0] = pack2hw(bfhi(Br[0][c2]) * wg[0], bfhi(Br[1][c2]) * wg[1]); q1[1] = pack2hw(bfhi(Br[2][c2]) * wg[2], bfhi(Br[3][c2]) * wg[3]);
                    *(u32x2*)(BTs + swz(co * 8 + 2 * c2, rg * 4)) = q0; *(u32x2*)(BTs + swz(co * 8 + 2 * c2 + 1, rg * 4)) = q1; }
#pragma unroll
                for (int r = 0; r < 4; ++r) { const int l = rg * 4 + r; const float cl = cumr[r]; u32x4 gv;
#pragma unroll
                    for (int c2 = 0; c2 < 4; ++c2) { const int s0 = co * 8 + 2 * c2;
                        const float cs0 = c2 < 2 ? cums0[2 * c2] : cums1[2 * c2 - 4], cs1 = c2 < 2 ? cums0[2 * c2 + 1] : cums1[2 * c2 - 3];
                        const bool v0 = d == 0 ? (s0 <= l) : (s0 >= l), v1 = d == 0 ? (s0 + 1 <= l) : (s0 + 1 >= l);
                        const float g0 = v0 ? bflo(Gr[r][c2]) * __expf(cl - cs0) : 0.f, g1 = v1 ? bfhi(Gr[r][c2]) * __expf(cl - cs1) : 0.f;
                        gv[c2] = pack2hw(g0, g1); }
                    *(u32x4*)(Gs + swz(l, co * 8)) = gv; }
                const int xo = tid & 7;
#pragma unroll
                for (int i = 0; i < 2; ++i) { const int l = (tid >> 3) + 64 * i;
#pragma unroll
                    for (int c2 = 0; c2 < 4; ++c2) { const u32 pr = pack2hw(bflo(Xr[i][c2]) * dtl[i], bfhi(Xr[i][c2]) * dtl[i]);
                        *(u16*)(XTs + swz(xo * 8 + 2 * c2, l)) = (u16)(pr & 0xFFFFu); *(u16*)(XTs + swz(xo * 8 + 2 * c2 + 1, l)) = (u16)(pr >> 16); } }
                if (tid < 128) { cum[tid] = cum128; dtv[tid] = dt128; }
            }
            if (ci + 1 < 66 && ci + 1 != 34) SSD_LOAD(ci + 1, tid);
            LDS_BARRIER();
            {
                bf16x8 afrag[4], gfrag[4];
#pragma unroll
                for (int kk = 0; kk < 4; ++kk) { afrag[kk] = *(const bf16x8*)(Cs + swz(wave * 16 + fr, kk * 32 + fq * 8)); gfrag[kk] = *(const bf16x8*)(Gs + swz(wave * 16 + fr, kk * 32 + fq * 8)); }
                const int l = wave * 16 + fr;
                const float e = __expf(cum[l]), rdt = Dh / dtv[l];
                u16* yrow = (ci < 2 && d == 1) ? YC1 + (size_t)(row0 - ML + l) * 2048 + xc0 : Y + (size_t)(row0 + l) * 2048 + xc0;
#pragma unroll
                for (int pt = 0; pt < 4; ++pt) {
                    f32x4 accD = (f32x4){0.f, 0.f, 0.f, 0.f}, accO = (f32x4){0.f, 0.f, 0.f, 0.f};
#pragma unroll
                    for (int kk = 0; kk < 4; ++kk) {
                        const bf16x8 xf = *(const bf16x8*)(XTs + swz(pt * 16 + fr, kk * 32 + fq * 8));
                        accD = __builtin_amdgcn_mfma_f32_16x16x32_bf16(xf, gfrag[kk], accD, 0, 0, 0);
                        const bf16x8 hb = *(const bf16x8*)(Hs + swz(pt * 16 + fr, kk * 32 + fq * 8));
                        accO = __builtin_amdgcn_mfma_f32_16x16x32_bf16(hb, afrag[kk], accO, 0, 0, 0);
                    }
                    const int p0 = pt * 16 + fq * 4;
                    float o[4];
                    if (ci >= 34) { const u32x2 yo = yold[pt];
                        o[0] = bflo(yo[0]) + accD[0] + e * accO[0]; o[1] = bfhi(yo[0]) + accD[1] + e * accO[1];
                        o[2] = bflo(yo[1]) + accD[2] + e * accO[2]; o[3] = bfhi(yo[1]) + accD[3] + e * accO[3]; }
                    else { const float dsk = (ci < 2 && d == 1) ? 0.f : rdt;
#pragma unroll
                        for (int jj = 0; jj < 4; ++jj) o[jj] = dsk * bf2f(*(const u16*)(XTs + swz(p0 + jj, l))) + accD[jj] + e * accO[jj]; }
                    u32x2 ov; ov[0] = pack2hw(o[0], o[1]); ov[1] = pack2hw(o[2], o[3]);
                    *(u32x2*)(yrow + p0) = ov;
                }
            }
            {
                if (ci + 1 < 66 && ci + 1 != 34) SSD_LOADY(ci + 1, tid);
                const float et = __expf(total);
                bf16x8 bb[4];
#pragma unroll
                for (int kk = 0; kk < 4; ++kk) bb[kk] = *(const bf16x8*)(BTs + swz(wave * 16 + fr, kk * 32 + fq * 8));
#pragma unroll
                for (int pt = 0; pt < 4; ++pt) {
                    f32x4 acc = hreg[pt] * et;
#pragma unroll
                    for (int kk = 0; kk < 4; ++kk) { const bf16x8 xf = *(const bf16x8*)(XTs + swz(pt * 16 + fr, kk * 32 + fq * 8));
                        acc = __builtin_amdgcn_mfma_f32_16x16x32_bf16(bb[kk], xf, acc, 0, 0, 0); }
                    hreg[pt] = acc;
                }
                LDS_BARRIER();
#pragma unroll
                for (int pt = 0; pt < 4; ++pt) { u32x2 hv; hv[0] = pack2hw(hreg[pt][0], hreg[pt][1]); hv[1] = pack2hw(hreg[pt][2], hreg[pt][3]);
                    *(u32x2*)(Hs + swz(pt * 16 + fr, wave * 16 + fq * 4)) = hv; }
            }
        }
#undef SSD_LOAD
#undef SSD_LOADY
#undef SSD_ROW0
    }
}
__device__ __forceinline__ void phase_ssd_gatenorm(const Params& p, int j) {
    const int lane = otid() & 63, gw = blockIdx.x * 8 + (otid() >> 6), nw = gridDim.x * 8;
    u16* Y = (u16*)(p.ws + OFF_Y); const u16* Z = (const u16*)(p.ws + OFF_Z); const float* ng = p.in[16] + (size_t)j * 2048;
    for (int row = gw; row < MT; row += nw) {
#pragma unroll
        for (int k = 0; k < 4; ++k) {
            const int c = k * 512 + lane * 8;
            const u32x4 yv = *(const u32x4*)(Y + (size_t)row * 2048 + c), zv = *(const u32x4*)(Z + (size_t)row * 2048 + c);
            float yf[8], zf[8], v[8]; unpack8(yv, yf); unpack8(zv, zf);
            if (row >= ML) { const u32x4 y1 = *(const u32x4*)((const u16*)(p.ws + OFF_YC1) + (size_t)(row - ML) * 2048 + c); float y1f[8]; unpack8(y1, y1f);
#pragma unroll
                for (int i = 0; i < 8; ++i) yf[i] += y1f[i]; }
            float ss = 0.f;
#pragma unroll
            for (int i = 0; i < 8; ++i) { v[i] = yf[i] * silu_f(zf[i]); ss += v[i] * v[i]; }
            ss = wave_sum(ss);
            const float rstd = rsqrtf(ss * (1.f / 512.f) + 1e-6f);
            const float4 g0 = *(const float4*)(ng + c), g1 = *(const float4*)(ng + c + 4);
            u32x4 o;
            o[0] = pack2(v[0] * rstd * g0.x, v[1] * rstd * g0.y); o[1] = pack2(v[2] * rstd * g0.z, v[3] * rstd * g0.w);
            o[2] = pack2(v[4] * rstd * g1.x, v[5] * rstd * g1.y); o[3] = pack2(v[6] * rstd * g1.z, v[7] * rstd * g1.w);
            *(u32x4*)(Y + (size_t)row * 2048 + c) = o;
        }
    }
}

template <int W> __device__ __forceinline__ void pool_lat_item(const u16* U, u16* PO, float* cs, size_t base, int r, int g, int cp, int cq) {
    const int HW = 1 << g;
#pragma unroll 2
    for (int ci = 0; ci < 16; ++ci) { const int c = cq + 4 * ci;
        u32 v[W];
#pragma unroll
        for (int k = 0; k < W; ++k) { const int rr = min(max(r - HW + k, 0), 127); v[k] = *(const u32*)(U + (base + rr * 64 + c) * 1024 + g * 256 + 2 * cp); }
        float s0 = 0.f, s1 = 0.f;
#pragma unroll
        for (int k = 0; k < W; ++k) { const int rr = r - HW + k; const float wt = (k < 2 * HW && rr >= 0 && rr < 128) ? 1.f : 0.f; s0 += wt * bflo(v[k]); s1 += wt * bfhi(v[k]); }
        cs[c * 256 + 2 * cp] = s0; cs[c * 256 + 2 * cp + 1] = s1; }
    __syncthreads();
    const int cnt_r = min(r + HW, 128) - max(r - HW, 0);
#pragma unroll 2
    for (int ci = 0; ci < 16; ++ci) { const int c = cq + 4 * ci;
        float s0 = 0.f, s1 = 0.f;
#pragma unroll
        for (int k = 0; k < W; ++k) { const int c2 = c - HW + k; const int cc = min(max(c2, 0), 63); const float wt = (k < 2 * HW && c2 >= 0 && c2 < 64) ? 1.f : 0.f;
            s0 += wt * cs[cc * 256 + 2 * cp]; s1 += wt * cs[cc * 256 + 2 * cp + 1]; }
        const int cnt_c = min(c + HW, 64) - max(c - HW, 0);
        const float inv = 1.f / ((float)cnt_r * (float)cnt_c);
        const size_t row = base + r * 64 + c;
        const u32 tk = *(const u32*)(U + row * 1024 + g * 256 + 2 * cp);
        *(u32*)(PO + row * 1024 + g * 256 + 2 * cp) = pack2(s0 * inv - bflo(tk), s1 * inv - bfhi(tk)); }
}
template <int W> __device__ __forceinline__ void pool_ctx_item(const u16* U, u16* PO, size_t base, int g, int cp, int cq) {
    const int HW = 1 << g;
#pragma unroll 2
    for (int i = 0; i < 64; ++i) { const int t = cq + 4 * i;
        u32 v[W];
#pragma unroll
        for (int k = 0; k < W; ++k) { const int sidx = min(max(t - HW + k, 0), 255); v[k] = *(const u32*)(U + (base + sidx) * 1024 + g * 256 + 2 * cp); }
        float s0 = 0.f, s1 = 0.f;
#pragma unroll
        for (int k = 0; k < W; ++k) { const int sidx = t - HW + k; const float wt = (k < 2 * HW && sidx >= 0 && sidx < 256) ? 1.f : 0.f; s0 += wt * bflo(v[k]); s1 += wt * bfhi(v[k]); }
        const float inv = 1.f / (float)(min(t + HW, 256) - max(t - HW, 0));
        const u32 tk = *(const u32*)(U + (base + t) * 1024 + g * 256 + 2 * cp);
        *(u32*)(PO + (base + t) * 1024 + g * 256 + 2 * cp) = pack2(s0 * inv - bflo(tk), s1 * inv - bfhi(tk)); }
}
__device__ __forceinline__ void phase_pool(const Params& p, unsigned char* lds) {
    float* cs = (float*)lds;
    const int tid = otid(), cp = tid & 127, cq = tid >> 7;
    const u16* U = (const u16*)(p.ws + OFF_U); u16* PO = (u16*)(p.ws + OFF_POOLED);
    for (int item = blockIdx.x; item < 2048 + 16; item += gridDim.x) {
        __syncthreads();
        if (item < 2048) {
            const int b = item >> 9, r = (item >> 2) & 127, g = item & 3;
            const size_t base = (size_t)b * 8192;
            if (g < 2) pool_lat_item<4>(U, PO, cs, base, r, g, cp, cq);
            else pool_lat_item<16>(U, PO, cs, base, r, g, cp, cq);
        } else {
            const int it = item - 2048, b = it >> 2, g = it & 3;
            const size_t base = (size_t)ML + b * 256;
            pool_ctx_item<16>(U, PO, base, g, cp, cq);
        }
    }
}

__device__ __forceinline__ float2 cmul(float2 a, float2 b) { return make_float2(a.x * b.x - a.y * b.y, a.x * b.y + a.y * b.x); }
__device__ __forceinline__ float2 twid(float turns) { return make_float2(__builtin_amdgcn_cosf(turns), __builtin_amdgcn_sinf(turns)); }
__device__ __forceinline__ void fft_fwd(const Params& p, float2* X) {
    const int tid = otid();
    for (int s = 8192; s >= 2; s >>= 2) {
        const int q = s >> 1, lq = __builtin_ctz(q); const float inv2s = 0.5f / (float)s, invs = 1.0f / (float)s;
#pragma unroll 4
        for (int it = 0; it < 8; ++it) {
            const int jx = tid + it * 512; const int grp = jx >> lq, pos = jx & (q - 1); const int i0 = grp * 2 * s + pos;
            const float2 a = X[i0], b = X[i0 + q], c = X[i0 + s], dd = X[i0 + s + q];
            const float2 tw = twid((float)pos * inv2s);
            const float2 w1 = make_float2(tw.x, -tw.y), w2 = make_float2(-tw.y, -tw.x), w3 = make_float2(tw.x * tw.x - tw.y * tw.y, -2.f * tw.x * tw.y);
            const float2 a1 = make_float2(a.x + c.x, a.y + c.y), c1 = cmul(make_float2(a.x - c.x, a.y - c.y), w1);
            const float2 b1 = make_float2(b.x + dd.x, b.y + dd.y), d1 = cmul(make_float2(b.x - dd.x, b.y - dd.y), w2);
            X[i0] = make_float2(a1.x + b1.x, a1.y + b1.y); X[i0 + q] = cmul(make_float2(a1.x - b1.x, a1.y - b1.y), w3);
            X[i0 + s] = make_float2(c1.x + d1.x, c1.y + d1.y); X[i0 + s + q] = cmul(make_float2(c1.x - d1.x, c1.y - d1.y), w3);
        }
        __syncthreads();
    }
}
__device__ __forceinline__ void fft_inv(const Params& p, float2* X) {
    const int tid = otid();
    for (int s = 2; s <= 8192; s <<= 2) {
        const int q = s >> 1, lq = __builtin_ctz(q); const float inv2s = 0.5f / (float)s, invs = 1.0f / (float)s;
#pragma unroll 4
        for (int it = 0; it < 8; ++it) {
            const int jx = tid + it * 512; const int grp = jx >> lq, pos = jx & (q - 1); const int i0 = grp * 2 * s + pos;
            const float2 a = X[i0], b = X[i0 + q], c = X[i0 + s], dd = X[i0 + s + q];
            const float2 w1 = twid((float)pos * inv2s), w2 = make_float2(-w1.y, w1.x), w3 = make_float2(w1.x * w1.x - w1.y * w1.y, 2.f * w1.x * w1.y);
            const float2 bw = cmul(b, w3), dw = cmul(dd, w3);
            const float2 a1 = make_float2(a.x + bw.x, a.y + bw.y), b1 = make_float2(a.x - bw.x, a.y - bw.y);
            const float2 c1 = make_float2(c.x + dw.x, c.y + dw.y), d1 = make_float2(c.x - dw.x, c.y - dw.y);
            const float2 cw = cmul(c1, w1), dw2 = cmul(d1, w2);
            X[i0] = make_float2(a1.x + cw.x, a1.y + cw.y); X[i0 + s] = make_float2(a1.x - cw.x, a1.y - cw.y);
            X[i0 + q] = make_float2(b1.x + dw2.x, b1.y + dw2.y); X[i0 + s + q] = make_float2(b1.x - dw2.x, b1.y - dw2.y);
        }
        __syncthreads();
    }
}
__device__ __forceinline__ int brev14(int k) { return (int)(__brev((unsigned)k) >> 18); }
__device__ __forceinline__ void spec_mul(const Params& p, float2* X, const float2* Ka, const float2* Kb) {
    const int tid = otid();
#pragma unroll 1
    for (int half = 0; half < 2; ++half) {
        float2 ka[8], kb[8];
#pragma unroll
        for (int i = 0; i < 8; ++i) { const int k = tid + 512 * (half * 8 + i); ka[i] = Ka[k]; kb[i] = Kb[k]; }
#pragma unroll
        for (int i = 0; i < 8; ++i) { const int k = tid + 512 * (half * 8 + i);
            const int pk = brev14(k), pm = brev14((16384 - k) & 16383);
            const float2 zk = X[pk], zm = X[pm];
            const float2 ua = make_float2(0.5f * (zk.x + zm.x), 0.5f * (zk.y - zm.y));
            const float2 ub = make_float2(0.5f * (zk.y + zm.y), -0.5f * (zk.x - zm.x));
            const float2 pa = cmul(ua, ka[i]), pb = cmul(ub, kb[i]);
            X[pk] = make_float2(pa.x - pb.y, pa.y + pb.x);
            X[pm] = make_float2(pa.x + pb.y, -pa.y + pb.x); }
    }
    if (tid == 0) { const int pk = brev14(8192);
        const float2 zk = X[pk];
        const float2 pa = cmul(make_float2(zk.x, 0.f), Ka[8192]), pb = cmul(make_float2(zk.y, 0.f), Kb[8192]);
        X[pk] = make_float2(pa.x - pb.y, pa.y + pb.x); }
    __syncthreads();
}
__device__ __forceinline__ void conv3x4(const u16* rowp, int n0, float w0, float w1, float w2, float bias, float (&out)[4]) {
    const u32x2 v = *(const u32x2*)(rowp + n0);
    const float c0 = bflo(v[0]), c1 = bfhi(v[0]), c2 = bflo(v[1]), c3 = bfhi(v[1]);
    const float l = n0 > 0 ? bf2f(rowp[n0 - 1]) : 0.f; const float r = n0 + 4 < 8192 ? bf2f(rowp[n0 + 4]) : 0.f;
    out[0] = bias + w0 * l + w1 * c0 + w2 * c1; out[1] = bias + w0 * c0 + w1 * c1 + w2 * c2;
    out[2] = bias + w0 * c1 + w1 * c2 + w2 * c3; out[3] = bias + w0 * c2 + w1 * c3 + w2 * r;
}
__device__ __forceinline__ float conv3_at(const u16* rowp, int n, int L, float w0, float w1, float w2, float bias) {
    const float c = bf2f(rowp[n]); const float l = n > 0 ? bf2f(rowp[n - 1]) : 0.f; const float r = n < L - 1 ? bf2f(rowp[n + 1]) : 0.f;
    return bias + w0 * l + w1 * c + w2 * r;
}
__device__ __forceinline__ void phase_hyena_lat(const Params& p, unsigned char* lds) {
    float2* X = (float2*)lds; float* aux = (float*)(lds + 131072);
    float* w3s = aux; float* red = aux + 512;
    const int tid = otid(), lane = tid & 63, wave = tid >> 6;
    const u16* PT = (const u16*)(p.ws + OFF_PT); u16* YT = (u16*)(p.ws + OFF_YT);
    float2* KF = (float2*)(p.ws + OFF_KF) + (size_t)blockIdx.x * 4 * KF_STRIDE;
    float2* ZS = (float2*)(p.ws + OFF_ZS) + (size_t)blockIdx.x * 8192;
    const float* HID2 = (const float*)(p.ws + OFF_HID2); const float* fw3 = p.in[28];
    for (int pair = blockIdx.x; pair < 512; pair += gridDim.x) {
        const int cha = 2 * pair;
        {
            float2* K1 = KF + (size_t)2 * KF_STRIDE;
            __syncthreads();
            { const int o = tid >> 8, which = (tid >> 6) & 3, jj = tid & 63; const int ch = cha + (which >> 1), dir = which & 1;
              w3s[tid] = fw3[(size_t)jj * 4096 + (o * 2 + dir) * 1024 + ch]; }
            __syncthreads();
            const float dela = 3.0701134573253945f + (float)cha * (12.280453829301578f / 1023.f);
            const float delb = 3.0701134573253945f + (float)(cha + 1) * (12.280453829301578f / 1023.f);
            float ss0a = 0.f, ss0b = 0.f, ss1a = 0.f, ss1b = 0.f;
#pragma unroll 1
            for (int i = 0; i < 16; ++i) {
                const int pos = tid + 512 * i;
                const float4* hr = (const float4*)(HID2 + (size_t)pos * 64);
                float d[8]; float4 hv[16];
#pragma unroll
                for (int q4 = 0; q4 < 16; ++q4) hv[q4] = hr[q4];
#pragma unroll
                for (int c = 0; c < 8; ++c) { float acc = 0.f; const float* wc = w3s + c * 64;
#pragma unroll
                    for (int q4 = 0; q4 < 16; ++q4) acc += hv[q4].x * wc[q4 * 4] + hv[q4].y * wc[q4 * 4 + 1] + hv[q4].z * wc[q4 * 4 + 2] + hv[q4].w * wc[q4 * 4 + 3];
                    asm volatile("" : "+v"(acc));
                    d[c] = acc; }
                const float t = (float)pos / 8191.f; const float ea = __expf(-t * dela), eb = __expf(-t * delb);
                const float h0a = d[0] * ea, h1a = d[1] * ea, h0b = d[2] * eb, h1b = d[3] * eb;
                const float g0a = d[4] * ea, g1a = d[5] * ea, g0b = d[6] * eb, g1b = d[7] * eb;
                ss0a += h0a * h0a + h1a * h1a; ss0b += h0b * h0b + h1b * h1b; ss1a += g0a * g0a + g1a * g1a; ss1b += g0b * g0b + g1b * g1b;
                X[pos] = make_float2(h0a, h0b); K1[pos] = make_float2(g0a, g0b);
                if (pos >= 1) { X[16384 - pos] = make_float2(h1a, h1b); K1[16384 - pos] = make_float2(g1a, g1b); }
            }
            if (tid == 0) { const float4 z4 = zerof4(); X[8192] = make_float2(z4.x, z4.y); K1[8192] = make_float2(z4.x, z4.y); }
            ss0a = wave_sum(ss0a); ss0b = wave_sum(ss0b); ss1a = wave_sum(ss1a); ss1b = wave_sum(ss1b);
            if (lane == 0) { red[wave] = ss0a; red[8 + wave] = ss0b; red[16 + wave] = ss1a; red[24 + wave] = ss1b; }
            __syncthreads();
#pragma unroll 1
            for (int o = 0; o < 2; ++o) {
                float ta = 0.f, tb = 0.f;
#pragma unroll
                for (int w = 0; w < 8; ++w) { ta += red[o * 16 + w]; tb += red[o * 16 + 8 + w]; }
                const float sa = rsqrtf(ta + 1e-6f), sb = rsqrtf(tb + 1e-6f);
                if (o == 1) {
                    __syncthreads();
                    float4* X4 = (float4*)X; const float4* K4 = (const float4*)(KF + (size_t)2 * KF_STRIDE);
#pragma unroll
                    for (int i = 0; i < 16; ++i) X4[tid + 512 * i] = K4[tid + 512 * i];
                    __syncthreads();
                }
                fft_fwd(p, X);
                float2* Ka = KF + (size_t)(o * 2) * KF_STRIDE; float2* Kb = Ka + KF_STRIDE;
                for (int k = tid; k <= 8192; k += 512) {
                    const int pk = brev14(k), pm = brev14((16384 - k) & 16383);
                    const float2 zk = X[pk], zm = X[pm];
                    Ka[k] = make_float2(sa * 0.5f * (zk.x + zm.x), sa * 0.5f * (zk.y - zm.y));
                    Kb[k] = make_float2(sb * 0.5f * (zk.y + zm.y), -sb * 0.5f * (zk.x - zm.x));
                }
            }
        }
        __threadfence_block();
        __syncthreads();
        const float* cw = p.in[22]; const float* cb = p.in[23]; const float* hbias = p.in[30];
        int tidc = tid; asm volatile("" : "+v"(tidc));
        float wv[2][3][4];
#pragma unroll
        for (int ab = 0; ab < 2; ++ab)
#pragma unroll
            for (int part = 0; part < 3; ++part) { const int cidx = part * 1024 + cha + ab;
                wv[ab][part][0] = cw[cidx]; wv[ab][part][1] = cw[3072 + cidx]; wv[ab][part][2] = cw[6144 + cidx]; wv[ab][part][3] = cb[cidx]; }
        const float hb0a = hbias[cha], hb0b = hbias[cha + 1], hb1a = hbias[1024 + cha], hb1b = hbias[1024 + cha + 1];
        for (int b = 0; b < 4; ++b) {
            const u16* va = PT + (size_t)cha * MT + (size_t)b * 8192; const u16* vb = va + MT;
            const u16* x1a = va + (size_t)1024 * MT; const u16* x1b = x1a + MT;
            const u16* x2a = va + (size_t)2048 * MT; const u16* x2b = x2a + MT;
            __syncthreads();
            float4* X4 = (float4*)X; float4* ZS4 = (float4*)ZS;
#pragma unroll
            for (int g = 0; g < 4; ++g) { const int n0 = 4 * (tidc + 512 * g);
                float a[4], c[4];
                conv3x4(va, n0, wv[0][0][0], wv[0][0][1], wv[0][0][2], wv[0][0][3], a); conv3x4(vb, n0, wv[1][0][0], wv[1][0][1], wv[1][0][2], wv[1][0][3], c);
                X4[n0 >> 1] = make_float4(a[0], c[0], a[1], c[1]); X4[(n0 >> 1) + 1] = make_float4(a[2], c[2], a[3], c[3]);
                X4[4096 + (n0 >> 1)] = zerof4(); X4[4096 + (n0 >> 1) + 1] = zerof4(); }
            __syncthreads();
            fft_fwd(p, X);
            spec_mul(p, X, KF, KF + KF_STRIDE);
            fft_inv(p, X);
#pragma unroll
            for (int g = 0; g < 4; ++g) { const int n0 = 4 * (tidc + 512 * g);
                float a[4], c[4], xa[4], xb[4];
                conv3x4(va, n0, wv[0][0][0], wv[0][0][1], wv[0][0][2], wv[0][0][3], a); conv3x4(vb, n0, wv[1][0][0], wv[1][0][1], wv[1][0][2], wv[1][0][3], c);
                conv3x4(x1a, n0, wv[0][1][0], wv[0][1][1], wv[0][1][2], wv[0][1][3], xa); conv3x4(x1b, n0, wv[1][1][0], wv[1][1][1], wv[1][1][2], wv[1][1][3], xb);
                const float4 q0 = X4[n0 >> 1], q1 = X4[(n0 >> 1) + 1];
                const float4 z0 = make_float4(xa[0] * (q0.x * (1.f / 16384.f) + a[0] * hb0a), xb[0] * (q0.y * (1.f / 16384.f) + c[0] * hb0b),
                                              xa[1] * (q0.z * (1.f / 16384.f) + a[1] * hb0a), xb[1] * (q0.w * (1.f / 16384.f) + c[1] * hb0b));
                const float4 z1 = make_float4(xa[2] * (q1.x * (1.f / 16384.f) + a[2] * hb0a), xb[2] * (q1.y * (1.f / 16384.f) + c[2] * hb0b),
                                              xa[3] * (q1.z * (1.f / 16384.f) + a[3] * hb0a), xb[3] * (q1.w * (1.f / 16384.f) + c[3] * hb0b));
                ZS4[n0 >> 1] = z0; ZS4[(n0 >> 1) + 1] = z1; X4[n0 >> 1] = z0; X4[(n0 >> 1) + 1] = z1;
                X4[4096 + (n0 >> 1)] = zerof4(); X4[4096 + (n0 >> 1) + 1] = zerof4(); }
            __syncthreads();
            fft_fwd(p, X);
            spec_mul(p, X, KF + 2 * KF_STRIDE, KF + 3 * KF_STRIDE);
            fft_inv(p, X);
#pragma unroll
            for (int g = 0; g < 4; ++g) { const int n0 = 4 * (tidc + 512 * g);
                float xa[4], xb[4];
                conv3x4(x2a, n0, wv[0][2][0], wv[0][2][1], wv[0][2][2], wv[0][2][3], xa); conv3x4(x2b, n0, wv[1][2][0], wv[1][2][1], wv[1][2][2], wv[1][2][3], xb);
                const float4 q0 = X4[n0 >> 1], q1 = X4[(n0 >> 1) + 1]; const float4 z0 = ZS4[n0 >> 1], z1 = ZS4[(n0 >> 1) + 1];
                u32x2 oa, ob;
                oa[0] = pack2(xa[0] * (q0.x * (1.f / 16384.f) + z0.x * hb1a), xa[1] * (q0.z * (1.f / 16384.f) + z0.z * hb1a));
                oa[1] = pack2(xa[2] * (q1.x * (1.f / 16384.f) + z1.x * hb1a), xa[3] * (q1.z * (1.f / 16384.f) + z1.z * hb1a));
                ob[0] = pack2(xb[0] * (q0.y * (1.f / 16384.f) + z0.y * hb1b), xb[1] * (q0.w * (1.f / 16384.f) + z0.w * hb1b));
                ob[1] = pack2(xb[2] * (q1.y * (1.f / 16384.f) + z1.y * hb1b), xb[3] * (q1.w * (1.f / 16384.f) + z1.w * hb1b));
                *(u32x2*)(YT + (size_t)cha * MT + (size_t)b * 8192 + n0) = oa;
                *(u32x2*)(YT + (size_t)(cha + 1) * MT + (size_t)b * 8192 + n0) = ob; }
        }
    }
}
__device__ __forceinline__ void phase_hyena_ctx(const Params& p, unsigned char* lds) {
    float* kf = (float*)lds;
    float* vs = kf + 1024; float* x1s = vs + 1024; float* x2s = x1s + 1024; float* zs = x2s + 1024; float* red = zs + 1024;
    const int tid = otid(), lane = tid & 63, wave = tid >> 6;
    const u16* PT = (const u16*)(p.ws + OFF_PT); u16* YT = (u16*)(p.ws + OFF_YT);
    const float* HID2C = (const float*)(p.ws + OFF_HID2C); const float* fw3 = p.in[28];
    const float* cw = p.in[22]; const float* cb = p.in[23]; const float* hbias = p.in[30];
    for (int ch = blockIdx.x; ch < 1024; ch += gridDim.x) {
        __syncthreads();
        {
            const int pos = tid & 255, o = tid >> 8;
            float* w3c = red + 16;
            if (tid < 256) w3c[tid] = fw3[(size_t)(tid & 63) * 4096 + (tid >> 6) * 1024 + ch];
            float4 hrow[16];
#pragma unroll
            for (int q4 = 0; q4 < 16; ++q4) hrow[q4] = *(const float4*)(HID2C + (size_t)pos * 64 + q4 * 4);
            __syncthreads();
            float d0 = 0.f, d1 = 0.f;
#pragma unroll
            for (int q4 = 0; q4 < 16; ++q4) { const float* wa = w3c + (o * 2) * 64 + q4 * 4; const float* wb = wa + 64;
                d0 += hrow[q4].x * wa[0] + hrow[q4].y * wa[1] + hrow[q4].z * wa[2] + hrow[q4].w * wa[3];
                d1 += hrow[q4].x * wb[0] + hrow[q4].y * wb[1] + hrow[q4].z * wb[2] + hrow[q4].w * wb[3]; }
            const float del = 3.0701134573253945f + (float)ch * (12.280453829301578f / 1023.f);
            const float e = __expf(-((float)pos / 255.f) * del);
            const float h0 = d0 * e, h1 = d1 * e;
            float ss = wave_sum(h0 * h0 + h1 * h1);
            if (lane == 0) red[wave] = ss;
            __syncthreads();
            const float tot = red[o * 4] + red[o * 4 + 1] + red[o * 4 + 2] + red[o * 4 + 3];
            const float sc = rsqrtf(tot + 1e-6f);
            kf[(o * 2) * 256 + pos] = h0 * sc; kf[(o * 2 + 1) * 256 + pos] = h1 * sc;
        }
        const float w00 = cw[ch], w01 = cw[3072 + ch], w02 = cw[6144 + ch], b0 = cb[ch];
        const float w10 = cw[1024 + ch], w11 = cw[3072 + 1024 + ch], w12 = cw[6144 + 1024 + ch], b1 = cb[1024 + ch];
        const float w20 = cw[2048 + ch], w21 = cw[3072 + 2048 + ch], w22 = cw[6144 + 2048 + ch], b2 = cb[2048 + ch];
        const float hb0 = hbias[ch], hb1 = hbias[1024 + ch];
#pragma unroll
        for (int r = 0; r < 2; ++r) { const int idx = tid + 512 * r, bb = idx >> 8, l = idx & 255;
            const u16* base = PT + (size_t)ch * MT + ML + bb * 256;
            vs[idx] = conv3_at(base, l, 256, w00, w01, w02, b0);
            x1s[idx] = conv3_at(base + (size_t)1024 * MT, l, 256, w10, w11, w12, b1);
            x2s[idx] = conv3_at(base + (size_t)2048 * MT, l, 256, w20, w21, w22, b2); }
        __syncthreads();
#pragma unroll
        for (int r = 0; r < 2; ++r) { const int idx = tid + 512 * r, bb = idx >> 8, l = idx & 255;
            float c = 0.f;
            for (int s = 0; s <= l; ++s) c += kf[l - s] * vs[bb * 256 + s];
            for (int s = l + 1; s < 256; ++s) c += kf[256 + s - l] * vs[bb * 256 + s];
            zs[idx] = x1s[idx] * (c + vs[idx] * hb0); }
        __syncthreads();
#pragma unroll
        for (int r = 0; r < 2; ++r) { const int idx = tid + 512 * r, bb = idx >> 8, l = idx & 255;
            float c = 0.f;
            for (int s = 0; s <= l; ++s) c += kf[512 + l - s] * zs[bb * 256 + s];
            for (int s = l + 1; s < 256; ++s) c += kf[768 + s - l] * zs[bb * 256 + s];
            YT[(size_t)ch * MT + ML + idx] = f2bf(x2s[idx] * (c + zs[idx] * hb1)); }
    }
}
__device__ __forceinline__ void phase_transpose_y(const Params& p, unsigned char* lds) {
    u16* tile = (u16*)lds;
    const int tid = otid();
    const u16* YT = (const u16*)(p.ws + OFF_YT); u16* Yh = (u16*)(p.ws + OFF_U);
    u32 v[4], nv[4];
    int t = blockIdx.x;
    if (t < 16 * 528) { const int c0 = (t / 528) << 6, r0 = (t % 528) << 6;
#pragma unroll
        for (int r = 0; r < 4; ++r) v[r] = *(const u32*)(YT + (size_t)(c0 + (tid >> 5) + 16 * r) * MT + r0 + (tid & 31) * 2); }
    for (; t < 16 * 528; t += gridDim.x) {
        const int c0 = (t / 528) << 6, r0 = (t % 528) << 6;
        const int tn = t + (int)gridDim.x;
        if (tn < 16 * 528) { const int c1 = (tn / 528) << 6, r1 = (tn % 528) << 6;
#pragma unroll
            for (int r = 0; r < 4; ++r) nv[r] = *(const u32*)(YT + (size_t)(c1 + (tid >> 5) + 16 * r) * MT + r1 + (tid & 31) * 2); }
        LDS_BARRIER();
#pragma unroll
        for (int r = 0; r < 4; ++r) { const int i = (tid >> 5) + 16 * r, j2 = (tid & 31) * 2; tile[i * 66 + j2] = (u16)(v[r] & 0xFFFFu); tile[i * 66 + j2 + 1] = (u16)(v[r] >> 16); }
        LDS_BARRIER();
#pragma unroll
        for (int r = 0; r < 4; ++r) { const int jt = (tid >> 5) + 16 * r, c2 = (tid & 31) * 2;
            *(u32*)(Yh + (size_t)(r0 + jt) * 1024 + c0 + c2) = (u32)tile[c2 * 66 + jt] | ((u32)tile[(c2 + 1) * 66 + jt] << 16); }
#pragma unroll
        for (int r = 0; r < 4; ++r) v[r] = nv[r];
    }
}

__global__ void __launch_bounds__(512, 2) hybrid_fwd(KArgs ka) {
    extern __shared__ __attribute__((aligned(16))) unsigned char shm[];
    cg::grid_group grid = cg::this_grid();
    Params p; p.in = (const float* const*)(ka.ws + OFF_TAB); p.out = ka.out; p.ws = ka.ws; p.wave = __builtin_amdgcn_readfirstlane((int)threadIdx.x >> 6);
    volatile PG8_LAS unsigned* st = (volatile PG8_LAS unsigned*)((PG8_LAS unsigned char*)shm + (LDS_BYTES - 16));
    if (threadIdx.x == 0) { st[0] = 0u; st[1] = 0u; }
    __syncthreads();
    (void)xcd_barrier_post((unsigned*)(p.ws + OFF_BAR), st);
#if PROBE
    unsigned long long* TS = (unsigned long long*)(p.ws + OFF_TS); int nsync = 0;
#define STAMP() do { if (blockIdx.x == 0 && threadIdx.x == 0) TS[nsync] = wall_clock64(); ++nsync; } while (0)
#else
#define STAMP() do { } while (0)
#endif
#define SYNC() do { XcdBarrier xb_; xb_.bar = (unsigned*)(p.ws + OFF_BAR); xb_.x = xb_xcc_id(); xb_.wave = p.wave; xb_.st = (volatile PG8_LAS unsigned*)((PG8_LAS unsigned char*)shm + (LDS_BYTES - 16)); xcd_barrier(xb_); STAMP(); asm volatile("" : "+s"(p.ws), "+s"(p.out), "+s"(p.in)); } while (0)
    u16* U = (u16*)(p.ws + OFF_U);
    float* Hc = (float*)(p.ws + OFF_HC);
    phase_setup(ka, shm, p.wave);
    grid.sync();
    STAMP();
    phase_modreduce(p);
    SYNC();
    int prev_nslice = 0;
#pragma unroll 1
    for (int layer = 0; layer < 4; ++layer) {
        const int kind = layer % 3, j = layer / 3;
        const float* modl = (const float*)(p.ws + OFF_MOD) + (size_t)layer * 5 * 9216;
#pragma unroll 1
        for (int sub = 0; sub < 3; ++sub) {
            if (sub == 0) convert_layer(p, layer, shm);
            const bool first = layer == 0 && sub == 0;
            phase_modulate(p, layer, sub, prev_nslice, first);
            SYNC();
            const u16* RA; const u16* RB; int RK; const float* rbias = (const float*)(p.ws + OFF_CONST); const float* rscale = rbias + 1024; float gmul;
            if (sub != 1) {
                const int f = sub == 0 ? 0 : 1;
                EpiFFN1 e1; e1.H = (u16*)(p.ws + OFF_HID);
                run_gemm(p.wave, shm, U, (const u16*)(p.ws + (f ? OFF_WGU1 : OFF_WGU0)), (layer == 3 && sub == 2) ? ML : MT, 5632, 1024, e1);
                SYNC();
                RA = (const u16*)(p.ws + OFF_HID); RB = (const u16*)(p.ws + (f ? OFF_WD1 : OFF_WD0)); RK = FF; gmul = 0.5f;
            } else {
                gmul = 1.0f;
                if (kind == 0) {
                    EpiSSDin es; es.Z = (u16*)(p.ws + OFF_Z); es.XBC = (u16*)(p.ws + OFF_XBC); es.DT = (float*)(p.ws + OFF_DT);
                    run_gemm(p.wave, shm, U, (const u16*)(p.ws + OFF_WM1), MT, 5376, 1024, es);
                    SYNC();
                    phase_ssd_prep1(p, j);
                    SYNC();
                    phase_ssd_prep2(p, j);
                    SYNC();
                    phase_ssd_cb(p, shm);
                    SYNC();
                    phase_ssd_scan(p, j, shm);
#if DBL_SCAN
                    if (layer == 0) phase_ssd_scan(p, j, shm);
#endif
                    SYNC();
                    phase_ssd_gatenorm(p, j);
                    SYNC();
                    RA = (const u16*)(p.ws + OFF_Y); RB = (const u16*)(p.ws + OFF_WM2); RK = 2048;
                } else if (kind == 1) {
                    phase_pool(p, shm);
                    SYNC();
                    RA = (const u16*)(p.ws + OFF_POOLED); RB = (const u16*)(p.ws + OFF_WM1); RK = 1024; rbias = p.in[19]; rscale = p.in[20];
                } else {
                    EpiBf16T et; et.O = (u16*)(p.ws + OFF_PT); et.ldc = MT;
                    run_gemm(p.wave, shm, (const u16*)(p.ws + OFF_WM1), U, 3072, MT, 1024, et);
                    SYNC();
                    phase_hyena_lat(p, shm);
#if DBL_HY
                    phase_hyena_lat(p, shm);
#endif
                    phase_hyena_ctx(p, shm);
                    SYNC();
                    phase_transpose_y(p, shm);
                    SYNC();
                    RA = U; RB = (const u16*)(p.ws + OFF_WM2); RK = 1024;
                }
            }
            {
                const bool ctx_live = !(layer == 3 && sub >= 1);
                const int nslice = RK >> 8, piece = (int)blockIdx.x;
                OneUnit os; os.has = ctx_live && piece < 16 * nslice;
                const int unit = os.has ? piece / nslice : 0, slice = os.has ? piece - unit * nslice : 0;
                os.u.pm = 128 + (unit >> 2); os.u.pn = unit & 3;
                const float* zeros = (const float*)(p.ws + OFF_CONST);
                const EpiResidPart ea{(float*)(p.ws + OFF_CPART) + (size_t)slice * 1024 * 1024, modl + (3 * sub + 2) * 1024, slice == 0 ? rbias : zeros, rscale, gmul, 0.f};
                Gemm g; g.A = RA + slice * 256; g.Bt = RB + slice * 256; g.M = MT; g.N = 1024; g.K = 256; g.ld = RK; g.wave = p.wave;
                gemm_phase<EpiResidPart, OneUnit>((PG8_LAS unsigned char*)shm, g, os, ea);
                prev_nslice = ctx_live ? nslice : 0;
            }
            const EpiResid er{p.out, first ? p.in[0] : (const float*)p.out, modl + (3 * sub + 2) * 1024, rbias, rscale, gmul, 0.f};
            run_gemm(p.wave, shm, RA, RB, ML, 1024, RK, er);
            SYNC();
        }
    }
    phase_final(p);
#if PROBE
    SYNC();
    if (blockIdx.x == 0) {
        const float t1 = (float)(TS[PROBE_P1] - TS[PROBE_P1 - 1]) * 0.01f, t2 = (float)(TS[PROBE_P2] - TS[PROBE_P2 - 1]) * 0.01f;
        if (threadIdx.x == 0) p.out[0] = 32.f * t1;
        for (int i = threadIdx.x; i < (1 << 20); i += 512) p.out[(1 << 20) + i] += t2;
    }
#endif
}

extern "C" void kernel_launch(void* const* d_in, const int* in_sizes, int n_in, void* d_out, int out_size, void* d_ws, size_t ws_size, hipStream_t stream) {
    static int grid_blocks = 0;
    if (grid_blocks == 0) {
        if (n_in != 33 || out_size != ML * 1024 || ws_size < WS_END) { fprintf(stderr, "kernel_launch: unexpected problem (n_in %d, out %d, ws %zu < %zu)\n", n_in, out_size, ws_size, (size_t)WS_END); grid_blocks = -1; return; }
        int dev = 0, cus = 0, per_cu = 0;
        hipGetDevice(&dev);
        hipDeviceGetAttribute(&cus, hipDeviceAttributeMultiprocessorCount, dev);
        if (hipFuncSetAttribute((const void*)hybrid_fwd, hipFuncAttributeMaxDynamicSharedMemorySize, LDS_BYTES) != hipSuccess) { fprintf(stderr, "kernel_launch: hipFuncSetAttribute failed\n"); grid_blocks = -1; return; }
        hipOccupancyMaxActiveBlocksPerMultiprocessor(&per_cu, (const void*)hybrid_fwd, 512, LDS_BYTES);
        if (per_cu < 1) { fprintf(stderr, "kernel_launch: occupancy query says %d blocks per CU\n", per_cu); per_cu = 1; }
        (void)hipGetLastError();
        if (cus < 256) { fprintf(stderr, "kernel_launch: this kernel is built for a 256-CU device (found %d CUs)\n", cus); grid_blocks = -1; return; }
        grid_blocks = 256;
    }
    if (grid_blocks < 0) return;
    KArgs p{};
    for (int i = 0; i < 33; ++i) p.in[i] = (const float*)d_in[i];
    p.out = (float*)d_out; p.ws = (unsigned char*)d_ws;
    if (hipMemsetAsync((char*)d_ws + OFF_BAR, 0, 16384, stream) != hipSuccess) { fprintf(stderr, "kernel_launch: memset failed\n"); return; }
    void* args[] = {&p};
    hipError_t e = hipLaunchCooperativeKernel((const void*)hybrid_fwd, dim3(grid_blocks), dim3(512), args, LDS_BYTES, stream);
    if (e != hipSuccess) fprintf(stderr, "cooperative launch failed: %s (grid %d)\n", hipGetErrorString(e), grid_blocks);
}
```

```cpp
#include <hip/hip_runtime.h>
#include <hip/hip_cooperative_groups.h>
#include <cstdio>
namespace cg = cooperative_groups;
__device__ __forceinline__ unsigned lane_id_now() { unsigned m = ~0u; asm volatile("" : "+v"(m)); return __builtin_amdgcn_mbcnt_hi(m, __builtin_amdgcn_mbcnt_lo(m, 0u)); }

#ifndef PROBE
#define PROBE 0
#endif
#ifndef PROBE_P1
#define PROBE_P1 7
#define PROBE_P2 27
#endif

#ifndef DBL_SCAN
#define DBL_SCAN 0
#endif
#ifndef DBL_HY
#define DBL_HY 0
#endif

namespace pg8 {
#define PG8_LAS __attribute__((address_space(3)))
typedef unsigned short bf16_t;
typedef short bf16x8 __attribute__((ext_vector_type(8)));
typedef float f32x4 __attribute__((ext_vector_type(4)));
typedef unsigned u32x4 __attribute__((ext_vector_type(4)));
constexpr int BM = 256, BK = 64, HALF = 128, HTB = HALF * BK * 2  , STAGE_BYTES = 8 * HTB, NXCD = 8, WGM = 8;

__host__ __device__ __forceinline__ int lds_byte(int r, int c) { const int st = (r >> 4) * 2 + (c >> 5), rr = r & 15, cc = c & 31, ob = rr * 64 + cc * 2; return st * 1024 + (ob ^ (((ob >> 9) & 1) << 5)); }
__host__ __device__ __forceinline__ void stage_rc(int b, int& R, int& C) { const int st = b / 1024, sb = b % 1024, swz = sb ^ (((sb >> 9) & 1) << 5); R = (st >> 1) * 16 + swz / 64; C = (st & 1) * 32 + (swz % 64) / 2; }
__host__ __device__ __forceinline__ int perm32(int rho) { const int n = rho >> 4, i = rho & 15; return 8 * (i >> 2) + 4 * n + (i & 3); }

struct Unit { int pm, pn; };
struct Gemm { const bf16_t* A; const bf16_t* Bt; int M, N, K, ld, wave; };
struct StaticOrder {
    int nM, nN, nwg, G, c;
    __host__ __device__ void init(int M, int N, int G_, int c_) { nM = M / BM; nN = N / BM; nwg = nM * nN; G = G_; c = c_; }
    __host__ __device__ bool next(int i, Unit& u) const {
        const long L = (long)i * G + c; if (L >= nwg) return false;
        int wgid = (int)L; { const int q = nwg / NXCD, r = nwg % NXCD, xcd = wgid % NXCD, off = wgid / NXCD; wgid = (xcd < r ? xcd * (q + 1) : r * (q + 1) + (xcd - r) * q) + off; }
        const int nig = WGM * nN, gid = wgid / nig, fm = gid * WGM, gsz = (nM - fm) < WGM ? (nM - fm) : WGM;
        u.pm = fm + ((wgid % nig) % gsz); u.pn = (wgid % nig) / gsz; return true;
    }
    __device__ __forceinline__ void a_ready(const Unit&) const {}
    __device__ __forceinline__ void done(const Unit&) const {}
};
__device__ __forceinline__ unsigned cvt_pk_bf16(float lo, float hi) { unsigned r; asm volatile("v_cvt_pk_bf16_f32 %0, %1, %2" : "=v"(r) : "v"(lo), "v"(hi)); return r; }
template <class Epi, class Sched>
__device__ __forceinline__ void gemm_phase(PG8_LAS unsigned char* lds, const Gemm g, const Sched S, const Epi E) {
    int tid_ = g.wave * 64 + (int)lane_id_now(); asm volatile("" : "+v"(tid_));
    const int tid = tid_, wid = __builtin_amdgcn_readfirstlane(tid >> 6), lane = tid & 63, wr = wid >> 2, wc = wid & 3, fr = lane & 15, fq = lane >> 4;
    const int K = g.K, nt = K / BK, LD = g.ld;
    unsigned voffA[2], voffB[2];
#pragma unroll
    for (int i = 0; i < 2; ++i) { int R, C; stage_rc(tid * 16 + i * 8192, R, C); const int Rb = Epi::PERM ? ((R & ~31) + perm32(R & 31)) : R;
        voffA[i] = (unsigned)(R * LD + C) * 2u; voffB[i] = (unsigned)(Rb * LD + C) * 2u; }
    const size_t kstep = (size_t)(BK * 2);
    const size_t hstep = (size_t)HALF * LD * 2;
    const size_t tstep = 2 * hstep;
    const unsigned ldsw = (unsigned)wid * 1024u;
    const int aoff = lds_byte(wr * 64 + fr, fq * 8), boff = lds_byte(wc * 32 + fr, fq * 8);
#define PG8_SA(b, h) (((b) * 2 + (h)) * HTB)
#define PG8_SB(b, h) ((4 + (b) * 2 + (h)) * HTB)
#define PG8_STAGE(bufoff, gbase, voff) do { _Pragma("unroll") for (int _i = 0; _i < 2; ++_i) \
        __builtin_amdgcn_global_load_lds((const unsigned*)((const char*)(gbase) + (voff)[_i]), (PG8_LAS unsigned*)(lds + (bufoff) + ldsw + _i * 8192), 16, 0, 0); } while (0)
#define PG8_LDA(dst, b, h) do { _Pragma("unroll") for (int m = 0; m < 4; ++m) _Pragma("unroll") for (int k = 0; k < 2; ++k) dst[m][k] = *(const PG8_LAS bf16x8*)(lds + PG8_SA(b, h) + aoff + m * 2048 + k * 1024); } while (0)
#define PG8_LDB(dst, b, h) do { _Pragma("unroll") for (int n = 0; n < 2; ++n) _Pragma("unroll") for (int k = 0; k < 2; ++k) dst[n][k] = *(const PG8_LAS bf16x8*)(lds + PG8_SB(b, h) + boff + n * 2048 + k * 1024); } while (0)
#define PG8_MMA(ai, bj, At, Bt) do { __builtin_amdgcn_s_setprio(1); _Pragma("unroll") for (int m = 0; m < 4; ++m) _Pragma("unroll") for (int n = 0; n < 2; ++n) _Pragma("unroll") for (int k = 0; k < 2; ++k) \
        acc[ai][bj][m][n] = __builtin_amdgcn_mfma_f32_16x16x32_bf16(Bt[n][k], At[m][k], acc[ai][bj][m][n], 0, 0, 0); __builtin_amdgcn_s_setprio(0); } while (0)
#define PG8_WAIT_V(n) asm volatile("s_waitcnt vmcnt(" #n ")" ::: "memory")
#define PG8_WAIT_L(n) asm volatile("s_waitcnt lgkmcnt(" #n ")" ::: "memory")
#define PG8_BAR __builtin_amdgcn_s_barrier()
#define PG8_SCHED __builtin_amdgcn_sched_barrier(0)
    Unit cur, nxt; int ui = 0;
    if (!S.next(0, cur)) return;
    f32x4 acc[2][2][4][2];
#pragma unroll
    for (int a = 0; a < 2; ++a)
#pragma unroll
        for (int b = 0; b < 2; ++b)
#pragma unroll
            for (int m = 0; m < 4; ++m)
#pragma unroll
                for (int n = 0; n < 2; ++n) acc[a][b][m][n] = (f32x4){0.f, 0.f, 0.f, 0.f};
    bf16x8 At[4][2], B0[2][2], B1[2][2];
    const char* cA = (const char*)g.A + (size_t)cur.pm * tstep; const char* cB = (const char*)g.Bt + (size_t)cur.pn * tstep;
    S.a_ready(cur);
    PG8_STAGE(PG8_SB(0, 0), cB, voffB); PG8_STAGE(PG8_SA(0, 0), cA, voffA); PG8_STAGE(PG8_SB(0, 1), cB + hstep, voffB); PG8_STAGE(PG8_SA(0, 1), cA + hstep, voffA);
    if (wr == 1) PG8_BAR;
    PG8_WAIT_V(4); PG8_BAR;
    PG8_STAGE(PG8_SB(1, 0), cB + kstep, voffB); PG8_STAGE(PG8_SA(1, 0), cA + kstep, voffA); PG8_STAGE(PG8_SB(1, 1), cB + hstep + kstep, voffB);
    PG8_WAIT_V(6); PG8_BAR;
    for (;;) {
        const bool has_next = S.next(ui + 1, nxt);
        const char* nA = has_next ? (const char*)g.A + (size_t)nxt.pm * tstep : cA; const char* nB = has_next ? (const char*)g.Bt + (size_t)nxt.pn * tstep : cB;
        for (int t = 0; t < nt; t += 2) {
            const bool last = (t == nt - 2);
            const char* a1 = cA + (size_t)(t + 1) * kstep;
            const char* a2 = last ? nA : cA + (size_t)(t + 2) * kstep; const char* b2 = last ? nB : cB + (size_t)(t + 2) * kstep;
            const char* a3 = a2 + kstep; const char* b3 = b2 + kstep;
            if (last && has_next) S.a_ready(nxt);
            PG8_LDB(B0, 0, 0); PG8_SCHED; PG8_LDA(At, 0, 0); PG8_STAGE(PG8_SA(1, 1), a1 + hstep, voffA);
            PG8_WAIT_L(8); PG8_BAR; PG8_WAIT_L(0); PG8_MMA(0, 0, At, B0); PG8_BAR; PG8_SCHED;
            PG8_LDB(B1, 0, 1); PG8_STAGE(PG8_SB(0, 0), b2, voffB);
            PG8_BAR; PG8_WAIT_L(0); PG8_MMA(0, 1, At, B1); PG8_BAR;
            PG8_LDA(At, 0, 1); PG8_STAGE(PG8_SA(0, 0), a2, voffA);
            PG8_BAR; PG8_WAIT_L(0); PG8_MMA(1, 0, At, B0); PG8_BAR; PG8_SCHED;
            PG8_STAGE(PG8_SB(0, 1), b2 + hstep, voffB);
            PG8_WAIT_V(6); PG8_BAR; PG8_MMA(1, 1, At, B1); PG8_BAR;
            PG8_LDB(B0, 1, 0); PG8_SCHED; PG8_LDA(At, 1, 0); PG8_STAGE(PG8_SA(0, 1), a2 + hstep, voffA);
            PG8_WAIT_L(8); PG8_BAR; PG8_WAIT_L(0); PG8_MMA(0, 0, At, B0); PG8_BAR; PG8_SCHED;
            PG8_LDB(B1, 1, 1); PG8_STAGE(PG8_SB(1, 0), b3, voffB);
            PG8_BAR; PG8_WAIT_L(0); PG8_MMA(0, 1, At, B1); PG8_BAR;
            PG8_LDA(At, 1, 1); PG8_STAGE(PG8_SA(1, 0), a3, voffA);
            PG8_BAR; PG8_WAIT_L(0); PG8_MMA(1, 0, At, B0); PG8_BAR; PG8_SCHED;
            PG8_STAGE(PG8_SB(1, 1), b3 + hstep, voffB);
            PG8_WAIT_V(6); PG8_BAR; PG8_MMA(1, 1, At, B1); PG8_BAR;
        }
        if constexpr (!Epi::AFTER_DRAIN) { E(acc, cur, wr, wc, fr, fq); S.done(cur); }
        if (!has_next) break;
#pragma unroll
        for (int a = 0; a < 2; ++a)
#pragma unroll
            for (int b = 0; b < 2; ++b)
#pragma unroll
                for (int m = 0; m < 4; ++m)
#pragma unroll
                    for (int n = 0; n < 2; ++n) acc[a][b][m][n] = (f32x4){0.f, 0.f, 0.f, 0.f};
        cur = nxt; cA = nA; cB = nB; ++ui;
    }
    PG8_WAIT_V(0);
    if (wr == 0) PG8_BAR;
    PG8_BAR;
    if constexpr (Epi::AFTER_DRAIN) { E.fused(acc, cur, wr, wc, fr, fq, lds, wid, lane); S.done(cur); }
#undef PG8_SA
#undef PG8_SB
#undef PG8_STAGE
#undef PG8_LDA
#undef PG8_LDB
#undef PG8_MMA
#undef PG8_WAIT_V
#undef PG8_WAIT_L
#undef PG8_BAR
#undef PG8_SCHED
}
}

using namespace pg8;
typedef unsigned short u16;
typedef unsigned u32;
typedef u32 u32x2 __attribute__((ext_vector_type(2)));
typedef float f32x2v __attribute__((ext_vector_type(2)));

constexpr int ML = 32768, MCX = 1024, MT = 33792, FF = 2816;
constexpr int LDS_BYTES = 159744;
constexpr size_t OFF_U = 0, SZ_U = (size_t)MT * 1024 * 2;
constexpr size_t OFF_BIG = OFF_U + SZ_U, SZ_BIG = (size_t)MT * 7168 * 2;
constexpr size_t SZ_WGU = (size_t)5632 * 1024 * 2, SZ_WD = (size_t)1024 * 2816 * 2;
constexpr size_t OFF_WGU0 = OFF_BIG + SZ_BIG, OFF_WD0 = OFF_WGU0 + SZ_WGU, OFF_WGU1 = OFF_WD0 + SZ_WD, OFF_WD1 = OFF_WGU1 + SZ_WGU;
constexpr size_t OFF_WM1 = OFF_WD1 + SZ_WD, SZ_WM1 = (size_t)5376 * 1024 * 2, OFF_WM2 = OFF_WM1 + SZ_WM1, SZ_WM2 = (size_t)2048 * 1024 * 2;
constexpr size_t OFF_MOD = OFF_WM2 + SZ_WM2, SZ_MOD = (size_t)4 * 5 * 9216 * 4;
constexpr size_t OFF_HC = OFF_MOD + SZ_MOD, SZ_HC = (size_t)1024 * 1024 * 4;
constexpr size_t OFF_DT = OFF_HC + SZ_HC, SZ_DT = (size_t)MT * 64 * 4;
constexpr size_t OFF_HID2 = OFF_DT + SZ_DT, SZ_HID2 = (size_t)8192 * 64 * 4;
constexpr size_t OFF_HID2C = OFF_HID2 + SZ_HID2, SZ_HID2C = (size_t)256 * 64 * 4;
constexpr size_t OFF_CONST = OFF_HID2C + SZ_HID2C;
constexpr size_t OFF_BAR = OFF_CONST + 8192;
constexpr size_t OFF_TS = OFF_BAR + 16384;
constexpr size_t OFF_TAB = OFF_TS + 1024;
constexpr size_t WS_END = OFF_TAB + 1024;
constexpr size_t OFF_HID = OFF_BIG;
constexpr size_t OFF_Z = OFF_BIG, OFF_XBC = OFF_BIG + (size_t)MT * 2048 * 2, OFF_Y = OFF_BIG + (size_t)MT * 5120 * 2;
constexpr size_t OFF_HALO = OFF_U, OFF_CUM = OFF_U + (size_t)8 * 1024 * 1024, OFF_CBG = OFF_U + (size_t)20 * 1024 * 1024, OFF_YC1 = OFF_U + (size_t)56 * 1024 * 1024;
constexpr size_t OFF_POOLED = OFF_BIG;
constexpr size_t OFF_PT = OFF_BIG, OFF_YT = OFF_BIG + (size_t)3072 * MT * 2, OFF_KF = OFF_BIG + (size_t)4096 * MT * 2;
constexpr size_t OFF_ZS = OFF_KF + (size_t)256 * 4 * 8200 * 8;
constexpr int KF_STRIDE = 8200;
constexpr size_t OFF_PART = OFF_BIG;
constexpr size_t OFF_CPART = OFF_BIG + (size_t)200 * 1024 * 1024;

__device__ __forceinline__ int otid_(int wave) { int t = wave * 64 + (int)lane_id_now(); asm volatile("" : "+v"(t)); return t; }
#define otid() otid_(p.wave)
#define LDS_BARRIER() asm volatile("s_waitcnt lgkmcnt(0)\n\ts_barrier" ::: "memory")
struct KArgs { const float* in[33]; float* out; unsigned char* ws; };
struct Params { const float* const* in; float* out; unsigned char* ws; int wave; };

__device__ __forceinline__ u16 f2bf(float f) { u32 u = __float_as_uint(f); u += 0x7FFFu + ((u >> 16) & 1u); return (u16)(u >> 16); }
__device__ __forceinline__ float bf2f(u16 b) { return __uint_as_float(((u32)b) << 16); }
__device__ __forceinline__ u32 pack2(float lo, float hi) { return (u32)f2bf(lo) | ((u32)f2bf(hi) << 16); }
__device__ __forceinline__ u32 pack2hw(float lo, float hi) { u32 r; asm("v_cvt_pk_bf16_f32 %0, %1, %2" : "=v"(r) : "v"(lo), "v"(hi)); return r; }
__device__ __forceinline__ float bflo(u32 v) { return __uint_as_float(v << 16); }
__device__ __forceinline__ float bfhi(u32 v) { return __uint_as_float(v & 0xFFFF0000u); }
__device__ __forceinline__ u32x4 zero4() { u32 z = 0u; asm volatile("" : "+v"(z)); u32x4 r; r[0] = z; r[1] = z; r[2] = z; r[3] = z; return r; }
__device__ __forceinline__ float4 zerof4() { float z = 0.f; asm volatile("" : "+v"(z)); return make_float4(z, z, z, z); }
__device__ __forceinline__ float silu_f(float x) { return x * __builtin_amdgcn_rcpf(1.f + __expf(-x)); }
__device__ __forceinline__ float wave_sum(float v) {
#pragma unroll
    for (int o = 32; o >= 1; o >>= 1) v += __shfl_xor(v, o);
    return v;
}

struct EpiFFN1 {
    static constexpr bool PERM = true, AFTER_DRAIN = false;
    u16* H;
    __device__ __forceinline__ void operator()(const f32x4 (&acc)[2][2][4][2], const Unit& u, int wr, int wc, int fr, int fq) const {
        const int row0 = u.pm * BM + wr * 64 + fr, col0 = u.pn * 128 + wc * 32 + 8 * fq;
#pragma unroll
        for (int ai = 0; ai < 2; ++ai)
#pragma unroll
            for (int m = 0; m < 4; ++m) {
                const f32x4 g0 = acc[ai][0][m][0], g1 = acc[ai][0][m][1], u0 = acc[ai][1][m][0], u1 = acc[ai][1][m][1];
                u32x4 o;
                o[0] = pack2hw(silu_f(g0[0]) * u0[0], silu_f(g0[1]) * u0[1]); o[1] = pack2hw(silu_f(g0[2]) * u0[2], silu_f(g0[3]) * u0[3]);
                o[2] = pack2hw(silu_f(g1[0]) * u1[0], silu_f(g1[1]) * u1[1]); o[3] = pack2hw(silu_f(g1[2]) * u1[2], silu_f(g1[3]) * u1[3]);
                *(u32x4*)(H + (size_t)(row0 + ai * HALF + m * 16) * FF + col0) = o;
            }
    }
};
struct EpiResid {
    static constexpr bool PERM = false, AFTER_DRAIN = false;
    float* X; const float* Xsrc; const float* gate0; const float* bias; const float* cscale; float gmul; float pad_;
    __device__ __forceinline__ void operator()(const f32x4 (&acc)[2][2][4][2], const Unit& u, int wr, int wc, int fr, int fq) const {
        const int b = u.pm >> 5;
        const float* gate = gate0 + b * 9216;
        const int row0 = u.pm * BM + wr * 64 + fr, col0 = u.pn * BM + wc * 32 + 4 * fq;
#pragma unroll
        for (int bj = 0; bj < 2; ++bj)
#pragma unroll
            for (int n = 0; n < 2; ++n) { const int c = col0 + bj * HALF + n * 16;
                const f32x4 gv = *(const f32x4*)(gate + c) * gmul;
                const f32x4 bv = *(const f32x4*)(bias + c);
                const f32x4 sv = *(const f32x4*)(cscale + c);
#pragma unroll
                for (int ai = 0; ai < 2; ++ai)
#pragma unroll
                    for (int m = 0; m < 4; ++m) { const size_t o = (size_t)(row0 + ai * HALF + m * 16) * 1024 + c;
                        const f32x4 v = (acc[ai][bj][m][n] + bv) * sv;
                        *(f32x4*)(X + o) = *(const f32x4*)(Xsrc + o) + gv * v; } }
    }
};
struct EpiResidPart {
    static constexpr bool PERM = false, AFTER_DRAIN = false;
    float* P; const float* gate0; const float* bias; const float* cscale; float gmul; float pad_;
    __device__ __forceinline__ void operator()(const f32x4 (&acc)[2][2][4][2], const Unit& u, int wr, int wc, int fr, int fq) const {
        const float* gate = gate0 + 4 * 9216;
        const int row0 = (u.pm - 128) * BM + wr * 64 + fr, col0 = u.pn * BM + wc * 32 + 4 * fq;
#pragma unroll
        for (int bj = 0; bj < 2; ++bj)
#pragma unroll
            for (int n = 0; n < 2; ++n) { const int c = col0 + bj * HALF + n * 16;
                const f32x4 gv = *(const f32x4*)(gate + c) * gmul;
                const f32x4 bv = *(const f32x4*)(bias + c);
                const f32x4 sv = *(const f32x4*)(cscale + c);
#pragma unroll
                for (int ai = 0; ai < 2; ++ai)
#pragma unroll
                    for (int m = 0; m < 4; ++m)
                        *(f32x4*)(P + (size_t)(row0 + ai * HALF + m * 16) * 1024 + c) = gv * ((acc[ai][bj][m][n] + bv) * sv); }
    }
};
struct OneUnit {
    Unit u; bool has;
    __device__ __forceinline__ bool next(int i, Unit& o) const { if (i == 0 && has) { o = u; return true; } return false; }
    __device__ __forceinline__ void a_ready(const Unit&) const {}
    __device__ __forceinline__ void done(const Unit&) const {}
};
struct EpiSSDin {
    static constexpr bool PERM = true, AFTER_DRAIN = false;
    u16* Z; u16* XBC; float* DT;
    __device__ __forceinline__ void operator()(const f32x4 (&acc)[2][2][4][2], const Unit& u, int wr, int wc, int fr, int fq) const {
        const int row0 = u.pm * BM + wr * 64 + fr, cw = wc * 32 + 8 * fq;
        if (u.pn < 20) {
            u16* base; int ld;
            if (u.pn < 8) { base = Z + u.pn * 256; ld = 2048; } else { base = XBC + (u.pn - 8) * 256; ld = 3072; }
#pragma unroll
            for (int ai = 0; ai < 2; ++ai)
#pragma unroll
                for (int m = 0; m < 4; ++m) { u16* rp = base + (size_t)(row0 + ai * HALF + m * 16) * ld + cw;
#pragma unroll
                    for (int bj = 0; bj < 2; ++bj) { const f32x4 v0 = acc[ai][bj][m][0], v1 = acc[ai][bj][m][1]; u32x4 o;
                        o[0] = pack2(v0[0], v0[1]); o[1] = pack2(v0[2], v0[3]); o[2] = pack2(v1[0], v1[1]); o[3] = pack2(v1[2], v1[3]);
                        *(u32x4*)(rp + bj * HALF) = o; } }
        } else if (wc < 2) {
#pragma unroll
            for (int ai = 0; ai < 2; ++ai)
#pragma unroll
                for (int m = 0; m < 4; ++m) { float* rp = DT + (size_t)(row0 + ai * HALF + m * 16) * 64 + cw;
                    *(f32x4*)(rp) = acc[ai][0][m][0]; *(f32x4*)(rp + 4) = acc[ai][0][m][1]; }
        }
    }
};
struct EpiBf16T {
    static constexpr bool PERM = true, AFTER_DRAIN = false;
    u16* O; int ldc;
    __device__ __forceinline__ void operator()(const f32x4 (&acc)[2][2][4][2], const Unit& u, int wr, int wc, int fr, int fq) const {
        const int row0 = u.pm * BM + wr * 64 + fr, col0 = u.pn * BM + wc * 32 + 8 * fq;
#pragma unroll
        for (int ai = 0; ai < 2; ++ai)
#pragma unroll
            for (int m = 0; m < 4; ++m) { u16* rp = O + (size_t)(row0 + ai * HALF + m * 16) * ldc + col0;
#pragma unroll
                for (int bj = 0; bj < 2; ++bj) { const f32x4 v0 = acc[ai][bj][m][0], v1 = acc[ai][bj][m][1]; u32x4 o;
                    o[0] = pack2(v0[0], v0[1]); o[1] = pack2(v0[2], v0[3]); o[2] = pack2(v1[0], v1[1]); o[3] = pack2(v1[2], v1[3]);
                    *(u32x4*)(rp + bj * HALF) = o; } }
    }
};
template <class Epi> __device__ __forceinline__ void run_gemm(int wave_, unsigned char* shm, const u16* A, const u16* Bt, int M, int N, int K, const Epi E) {
    StaticOrder S; S.init(M, N, (int)gridDim.x, (int)blockIdx.x);
    Gemm g; g.A = A; g.Bt = Bt; g.M = M; g.N = N; g.K = K; g.ld = K; g.wave = wave_;
    gemm_phase<Epi, StaticOrder>((PG8_LAS unsigned char*)shm, g, S, E);
}

__device__ __forceinline__ void phase_setup(const KArgs& p, unsigned char* shm, int wave_) {
    const int tid = otid_(wave_);
    if (blockIdx.x == 0 && tid < 33) ((const float**)(p.ws + OFF_TAB))[tid] = p.in[tid];
    float* fl = (float*)shm;
    if (blockIdx.x == 0) { float* cz = (float*)(p.ws + OFF_CONST); for (int i = tid; i < 2048; i += 512) cz[i] = i < 1024 ? 0.f : 1.f; }
    {
        const float* cvec = p.in[1]; const float* cctx = p.in[3]; const float* aw = p.in[4];
        float* part = (float*)(p.ws + OFF_PART);
        for (int it = blockIdx.x; it < 576; it += gridDim.x) {
            const int layer = it / 144, rem = it % 144, cc = rem >> 3, kc = rem & 7;
            __syncthreads();
            for (int i = tid; i < 640; i += 512) { const int r = i >> 7, k = i & 127; const float v = r < 4 ? cvec[r * 1024 + kc * 128 + k] : cctx[kc * 128 + k]; fl[i] = silu_f(v); }
            __syncthreads();
            const int col = cc * 512 + tid;
            float a0 = 0.f, a1 = 0.f, a2 = 0.f, a3 = 0.f, a4 = 0.f;
            const float* wp = aw + ((size_t)layer * 1024 + kc * 128) * 9216 + col;
#pragma unroll 8
            for (int k = 0; k < 128; ++k) { const float w = wp[(size_t)k * 9216]; a0 += fl[k] * w; a1 += fl[128 + k] * w; a2 += fl[256 + k] * w; a3 += fl[384 + k] * w; a4 += fl[512 + k] * w; }
            float* po = part + ((size_t)(kc * 4 + layer) * 5) * 9216 + col;
            po[0] = a0; po[9216] = a1; po[2 * 9216] = a2; po[3 * 9216] = a3; po[4 * 9216] = a4;
        }
    }
    {
        const float* fw1 = p.in[24]; const float* fb1 = p.in[25]; const float* fw2 = p.in[26]; const float* fb2 = p.in[27]; const float* fq = p.in[29];
        float* zs = fl + 1024; float* h1s = fl + 1024 + 8 * 36;
        const int pl = tid >> 6, jx = tid & 63;
        for (int grp = blockIdx.x; grp < 1056; grp += gridDim.x) {
            int L, pos; float* outp;
            if (grp < 1024) { L = 8192; pos = grp * 8 + pl; outp = (float*)(p.ws + OFF_HID2) + (size_t)pos * 64; }
            else { L = 256; pos = (grp - 1024) * 8 + pl; outp = (float*)(p.ws + OFF_HID2C) + (size_t)pos * 64; }
            __syncthreads();
            if (jx < 33) {
                float zv;
                if (jx == 0) zv = (float)pos / (float)(L - 1);
                else { const int k = (jx - 1) & 15; const float f = 1e-4f + (float)k * ((15.0f - 1e-4f) / 15.0f);
                    const float wpos = (6.283185307179586f * (float)pos) / (float)L; const float ang = wpos * f;
                    zv = jx <= 16 ? cosf(ang) : -sinf(ang); }
                zs[pl * 36 + jx] = zv;
            }
            __syncthreads();
            float a = fb1[jx];
            for (int i = 0; i < 33; ++i) a += zs[pl * 36 + i] * fw1[i * 64 + jx];
            h1s[pl * 64 + jx] = sinf(fq[jx] * a);
            __syncthreads();
            float a2 = fb2[jx];
            for (int i = 0; i < 64; ++i) a2 += h1s[pl * 64 + i] * fw2[i * 64 + jx];
            outp[jx] = sinf(fq[64 + jx] * a2);
        }
    }
}
__device__ __forceinline__ void phase_modreduce(const Params& p) {
    const float* part = (const float*)(p.ws + OFF_PART); const float* ab = p.in[5]; float* mod = (float*)(p.ws + OFF_MOD);
    for (int idx = blockIdx.x * 512 + otid(); idx < 4 * 5 * 9216; idx += gridDim.x * 512) {
        const int layer = idx / 46080, col = idx % 9216;
        float s = ab[layer * 9216 + col];
#pragma unroll
        for (int kc = 0; kc < 8; ++kc) s += part[(size_t)kc * 184320 + idx];
        mod[idx] = s;
    }
}

__device__ __forceinline__ void convert_job(const Params& p, const float* src, int K, int N, int lds_, u16* dst, int ldd, int nmul, int noff, int koff, unsigned char* shm) {
    float* tile = (float*)shm;
    const int tid = otid(), tk = K >> 6, tn = N >> 6, nt = tk * tn;
    float v[8], nv[8];
    int t = blockIdx.x;
    if (t < nt) { const int k0 = (t / tn) << 6, n0 = (t % tn) << 6;
#pragma unroll
        for (int r = 0; r < 8; ++r) v[r] = src[(size_t)(k0 + (tid >> 6) + 8 * r) * lds_ + n0 + (tid & 63)]; }
    for (; t < nt; t += gridDim.x) {
        const int k0 = (t / tn) << 6, n0 = (t % tn) << 6;
        const int t2 = t + (int)gridDim.x;
        if (t2 < nt) { const int k1 = (t2 / tn) << 6, n1 = (t2 % tn) << 6;
#pragma unroll
            for (int r = 0; r < 8; ++r) nv[r] = src[(size_t)(k1 + (tid >> 6) + 8 * r) * lds_ + n1 + (tid & 63)]; }
        LDS_BARRIER();
#pragma unroll
        for (int r = 0; r < 8; ++r) tile[((tid >> 6) + 8 * r) * 65 + (tid & 63)] = v[r];
        LDS_BARRIER();
#pragma unroll
        for (int r = 0; r < 4; ++r) { const int jn = (tid >> 5) + 16 * r, ik = (tid & 31) * 2; const int n = n0 + jn;
            const int nd = (n >> 7) * nmul + noff + (n & 127);
            *(u32*)(dst + (size_t)nd * ldd + koff + k0 + ik) = pack2(tile[ik * 65 + jn], tile[(ik + 1) * 65 + jn]); }
#pragma unroll
        for (int r = 0; r < 8; ++r) v[r] = nv[r];
    }
    __syncthreads();
}
__device__ __forceinline__ void convert_layer(const Params& p, int layer, unsigned char* shm) {
    const int kind = layer % 3, j = layer / 3;
    u16* wm1 = (u16*)(p.ws + OFF_WM1); u16* wm2 = (u16*)(p.ws + OFF_WM2);
    if (kind == 1) {
        for (int t = blockIdx.x; t < 192; t += gridDim.x) {
            const int ob = t >> 4, piece = t & 15; const int gr = ob / 3, gcr = ob % 3; const int gc = gcr + (gcr >= gr ? 1 : 0);
            const int tid = otid(); const int r = piece * 16 + (tid >> 5), c8 = (tid & 31) * 8;
            *(u32x4*)(wm1 + (size_t)(gr * 256 + r) * 1024 + gc * 256 + c8) = zero4();
        }
    }
    const int njobs = kind == 1 ? 10 : 8;
#pragma unroll 1
    for (int jb = 0; jb < njobs; ++jb) {
        const float* src; int K, N, ld, ldd, nmul = 128, noff = 0, koff = 0; u16* dst;
        if (jb < 6) { const int f = jb / 3, w = jb - 3 * f; const size_t wo = (size_t)(layer * 2 + f) * 1024 * FF;
            u16* wgu = (u16*)(p.ws + (f ? OFF_WGU1 : OFF_WGU0)); u16* wd = (u16*)(p.ws + (f ? OFF_WD1 : OFF_WD0));
            if (w < 2) { src = p.in[7 + w] + wo; K = 1024; N = FF; ld = FF; dst = wgu; ldd = 1024; nmul = 256; noff = w * 128; }
            else { src = p.in[9] + wo; K = FF; N = 1024; ld = 1024; dst = wd; ldd = FF; }
        } else if (kind == 0) {
            if (jb == 6) { src = p.in[10] + (size_t)j * 1024 * 5184; K = 1024; N = 5184; ld = 5184; dst = wm1; ldd = 1024; }
            else { src = p.in[17] + (size_t)j * 2048 * 1024; K = 2048; N = 1024; ld = 1024; dst = wm2; ldd = 2048; }
        } else if (kind == 1) { const int g = jb - 6;
            src = p.in[18] + (size_t)g * 65536; K = 256; N = 256; ld = 256; dst = wm1; ldd = 1024; noff = g * 256; koff = g * 256;
        } else {
            if (jb == 6) { src = p.in[21]; K = 1024; N = 3072; ld = 3072; dst = wm1; ldd = 1024; }
            else { src = p.in[31]; K = 1024; N = 1024; ld = 1024; dst = wm2; ldd = 1024; }
        }
        convert_job(p, src, K, N, ld, dst, ldd, nmul, noff, koff, shm);
    }
}

__device__ __forceinline__ void phase_modulate(const Params& p, int layer, int which, int nslice, bool first) {
    const int lane = otid() & 63, gw = blockIdx.x * 8 + (otid() >> 6), nw = gridDim.x * 8;
    const float* g = p.in[6] + (size_t)(layer * 3 + which) * 1024;
    const float* mod = (const float*)(p.ws + OFF_MOD) + (size_t)layer * 5 * 9216;
    const float* Hc = first ? p.in[2] : (const float*)(p.ws + OFF_HC); const float* Xl = first ? p.in[0] : (const float*)p.out; u16* U = (u16*)(p.ws + OFF_U);
    const int r0 = gw, r1 = MT;
    float4 A[4], H[4], v[4], nv[4]; int cb = -1;
    { const float* xr = r0 < ML ? Xl + (size_t)r0 * 1024 : Hc + (size_t)(r0 - ML) * 1024;
#pragma unroll
      for (int k = 0; k < 4; ++k) v[k] = *(const float4*)(xr + k * 256 + lane * 4); }
    for (int row = r0; row < r1; row += nw) {
        if (row + nw < r1) { const int rn = row + nw; const float* xr = rn < ML ? Xl + (size_t)rn * 1024 : Hc + (size_t)(rn - ML) * 1024;
#pragma unroll
            for (int k = 0; k < 4; ++k) nv[k] = *(const float4*)(xr + k * 256 + lane * 4); }
        const int b = row < ML ? (row >> 13) : 4;
        if (b != cb) { cb = b; const float* sh = mod + (size_t)b * 9216 + (3 * which) * 1024; const float* sc = sh + 1024;
#pragma unroll
            for (int k = 0; k < 4; ++k) { const int c = k * 256 + lane * 4; const float4 g4 = *(const float4*)(g + c), s4 = *(const float4*)(sc + c); H[k] = *(const float4*)(sh + c);
                A[k] = make_float4(g4.x * (1.f + s4.x), g4.y * (1.f + s4.y), g4.z * (1.f + s4.z), g4.w * (1.f + s4.w)); } }
        if (row >= ML && (nslice > 0 || first)) {
            const float* pp = (const float*)(p.ws + OFF_CPART) + (size_t)(row - ML) * 1024 + lane * 4;
#pragma unroll 1
            for (int s0 = 0; s0 < nslice; s0 += 4) {
                float4 q[4][4];
#pragma unroll
                for (int jq = 0; jq < 4; ++jq) { const int sl = min(s0 + jq, nslice - 1);
#pragma unroll
                    for (int k = 0; k < 4; ++k) q[jq][k] = *(const float4*)(pp + (size_t)sl * 1024 * 1024 + k * 256); }
#pragma unroll
                for (int jq = 0; jq < 4; ++jq) { const float wq = (s0 + jq < nslice) ? 1.f : 0.f;
#pragma unroll
                    for (int k = 0; k < 4; ++k) { v[k].x += wq * q[jq][k].x; v[k].y += wq * q[jq][k].y; v[k].z += wq * q[jq][k].z; v[k].w += wq * q[jq][k].w; } }
            }
            float* xw = (float*)(p.ws + OFF_HC) + (size_t)(row - ML) * 1024;
#pragma unroll
            for (int k = 0; k < 4; ++k) *(float4*)(xw + k * 256 + lane * 4) = v[k];
        }
        float ss = 0.f;
#pragma unroll
        for (int k = 0; k < 4; ++k) ss += v[k].x * v[k].x + v[k].y * v[k].y + v[k].z * v[k].z + v[k].w * v[k].w;
        ss = wave_sum(ss);
        const float rstd = rsqrtf(ss * (1.f / 1024.f) + 1e-6f);
#pragma unroll
        for (int k = 0; k < 4; ++k) { const int c = k * 256 + lane * 4;
            u32x2 o;
            o[0] = pack2(v[k].x * rstd * A[k].x + H[k].x, v[k].y * rstd * A[k].y + H[k].y);
            o[1] = pack2(v[k].z * rstd * A[k].z + H[k].z, v[k].w * rstd * A[k].w + H[k].w);
            *(u32x2*)(U + (size_t)row * 1024 + c) = o; }
#pragma unroll
        for (int k = 0; k < 4; ++k) v[k] = nv[k];
    }
}
__device__ __forceinline__ void phase_final(const Params& p) {
    const int lane = otid() & 63, gw = blockIdx.x * 8 + (otid() >> 6), nw = gridDim.x * 8;
    const float* g = p.in[32];
    for (int row = gw; row < ML; row += nw) {
        float* xr = p.out + (size_t)row * 1024;
        float4 v[4]; float ss = 0.f;
#pragma unroll
        for (int k = 0; k < 4; ++k) { v[k] = *(const float4*)(xr + k * 256 + lane * 4); ss += v[k].x * v[k].x + v[k].y * v[k].y + v[k].z * v[k].z + v[k].w * v[k].w; }
        ss = wave_sum(ss);
        const float rstd = rsqrtf(ss * (1.f / 1024.f) + 1e-6f);
#pragma unroll
        for (int k = 0; k < 4; ++k) { const int c = k * 256 + lane * 4; const float4 g4 = *(const float4*)(g + c);
            float4 o; o.x = v[k].x * rstd * g4.x; o.y = v[k].y * rstd * g4.y; o.z = v[k].z * rstd * g4.z; o.w = v[k].w * rstd * g4.w;
            *(float4*)(xr + c) = o; }
    }
}

#define XB_TMO      128
#define XB_XCNT(j)  (256  + 64 * (j))
#define XB_XSUB(j)  (1280 + 64 * (j))
#define XB_XGEN(j)  (2304 + 64 * (j))
#define XB_TOP      3328
#define XB_TOPGEN   3392
#define XCD_BAR_WORDS 3456
#define XB_SPIN_CAP (1u << 18)

__device__ __forceinline__ unsigned xb_ld(unsigned* p)              { return __hip_atomic_load(p, __ATOMIC_RELAXED, __HIP_MEMORY_SCOPE_AGENT); }
__device__ __forceinline__ unsigned xb_add(unsigned* p, unsigned v) { return __hip_atomic_fetch_add(p, v, __ATOMIC_RELAXED, __HIP_MEMORY_SCOPE_AGENT); }
__device__ __forceinline__ unsigned xb_xcc_id() { return (unsigned)__builtin_amdgcn_s_getreg((3 << 11) | 20) & 0xFu; }
#define XB_SPIN(cond, bar) do { unsigned _sp = 0; while (cond) { __builtin_amdgcn_s_sleep(1); \
    if ((++_sp & 255u) == 0u) { if (xb_ld(&(bar)[XB_TMO])) break; if (_sp > XB_SPIN_CAP) { atomicAdd(&(bar)[XB_TMO], 1u); break; } } } } while (0)

struct XcdBarrier {
    unsigned* bar; unsigned x; int wave;
    volatile PG8_LAS unsigned* st;
};

__device__ __forceinline__ XcdBarrier xcd_barrier_post(unsigned* bar, volatile PG8_LAS unsigned* st) {
    XcdBarrier b; b.bar = bar; b.x = xb_xcc_id(); b.st = st;
    if (threadIdx.x == 0) (void)xb_add(&bar[XB_XCNT(b.x)], 1u);
    return b;
}
__device__ __forceinline__ void xcd_barrier_complete(unsigned* bar, unsigned x, unsigned& nloc, unsigned& nx) {
    const unsigned G = gridDim.x * gridDim.y * gridDim.z;
    unsigned sum, cnt, mine, sp = 0u;
    for (;;) {
        sum = 0u; cnt = 0u; mine = 0u;
#pragma unroll
        for (unsigned j = 0; j < 16; ++j) { const unsigned c = xb_ld(&bar[XB_XCNT(j)]); sum += c; cnt += (c > 0u) ? 1u : 0u; mine = (j == x) ? c : mine; }
        if (sum == G) break;
        __builtin_amdgcn_s_sleep(1);
        if ((++sp & 255u) == 0u) { if (xb_ld(&bar[XB_TMO])) break; if (sp > XB_SPIN_CAP) { atomicAdd(&bar[XB_TMO], 1u); break; } }
    }
    nloc = mine > 0u ? mine : 1u; nx = cnt > 0u ? cnt : 1u;
}

__device__ __forceinline__ void xcd_barrier(const XcdBarrier& b) {
    asm volatile("s_waitcnt vmcnt(0)" ::: "memory");
    __syncthreads();
    if (b.wave == 0 && lane_id_now() == 0u) {
        unsigned* bar = b.bar;
        __builtin_amdgcn_s_waitcnt(0);
        unsigned nloc = b.st[0], nx = b.st[1];
        if (nloc == 0u) { xcd_barrier_complete(bar, b.x, nloc, nx); b.st[0] = nloc; b.st[1] = nx; }
        const unsigned old = xb_add(&bar[XB_XSUB(b.x)], 1u);
        const unsigned gen = old / nloc;
        if (old + 1u == (gen + 1u) * nloc) {
            __builtin_amdgcn_fence(__ATOMIC_RELEASE, "agent");
            asm volatile("s_waitcnt vmcnt(0)" ::: "memory");
            const unsigned og = xb_add(&bar[XB_TOP], 1u);
            const unsigned tg = og / nx;
            if (og + 1u == (tg + 1u) * nx) xb_add(&bar[XB_TOPGEN], 1u);
            else XB_SPIN(xb_ld(&bar[XB_TOPGEN]) == tg, bar);
            __builtin_amdgcn_fence(__ATOMIC_ACQUIRE, "agent");
            xb_add(&bar[XB_XGEN(b.x)], 1u);
            asm volatile("s_waitcnt vmcnt(0)" ::: "memory");
        } else {
            XB_SPIN(xb_ld(&bar[XB_XGEN(b.x)]) == gen, bar);
            __builtin_amdgcn_fence(__ATOMIC_ACQUIRE, "agent");
            asm volatile("s_waitcnt vmcnt(0)" ::: "memory");
        }
    }
    __syncthreads();
}


__device__ __forceinline__ int swz(int row, int col) { return row * 256 + ((((col >> 3) ^ (row & 15))) << 4) + ((col & 7) << 1); }
__device__ __forceinline__ void unpack8(const u32x4 v, float (&f)[8]) {
    f[0] = bflo(v[0]); f[1] = bfhi(v[0]); f[2] = bflo(v[1]); f[3] = bfhi(v[1]); f[4] = bflo(v[2]); f[5] = bfhi(v[2]); f[6] = bflo(v[3]); f[7] = bfhi(v[3]);
}
__device__ __forceinline__ void phase_ssd_prep1(const Params& p, int j) {
    const int tid = otid();
    const u16* XBC = (const u16*)(p.ws + OFF_XBC); u16* HALO = (u16*)(p.ws + OFF_HALO);
    for (int idx = blockIdx.x * 512 + tid; idx < 264 * 4 * 384; idx += gridDim.x * 512) {
        const int q = idx / 1536, rem = idx - q * 1536, hr = rem / 384, v = rem - hr * 384;
        const int row = q * 128 + (hr < 2 ? hr - 2 : 126 + hr);
        int seg_lo, seg_hi;
        if (q < 256) { seg_lo = (q >> 6) * 8192; seg_hi = seg_lo + 8192; } else { seg_lo = ML + ((q - 256) >> 1) * 256; seg_hi = seg_lo + 256; }
        u32x4 val = zero4();
        if (row >= seg_lo && row < seg_hi) val = *(const u32x4*)(XBC + (size_t)row * 3072 + v * 8);
        *(u32x4*)(HALO + (size_t)(q * 4 + hr) * 3072 + v * 8) = val;
    }
    float* DT = (float*)(p.ws + OFF_DT); float* CUM = (float*)(p.ws + OFF_CUM);
    for (int gid = blockIdx.x * 512 + tid; gid < 264 * 64; gid += gridDim.x * 512) {
        const int q = gid >> 6, col = gid & 63, d = col >> 5;
        const float Aneg = -__expf(p.in[13][j * 64 + col]), dtb = p.in[14][j * 64 + col];
        float s = 0.f;
#pragma unroll 1
        for (int i0 = 0; i0 < 128; i0 += 16) {
            float raw[16];
#pragma unroll
            for (int k = 0; k < 16; ++k) { const int l = d == 0 ? i0 + k : 127 - i0 - k; raw[k] = DT[(size_t)(q * 128 + l) * 64 + col]; }
#pragma unroll
            for (int k = 0; k < 16; ++k) { const int l = d == 0 ? i0 + k : 127 - i0 - k; const size_t o = (size_t)(q * 128 + l) * 64 + col;
                const float r = raw[k] + dtb; const float dt = r > 20.f ? r : log1pf(__expf(r));
                s += dt * Aneg; DT[o] = dt; CUM[(size_t)(q * 64 + col) * 128 + l] = s; }
        }
    }
}
__device__ __forceinline__ void phase_ssd_prep2(const Params& p, int j) {
    const int tid = otid(), co = tid & 31, rg = tid >> 5;
    u16* XBC = (u16*)(p.ws + OFF_XBC); const u16* HALO = (const u16*)(p.ws + OFF_HALO);
    const float* conv_w = p.in[11] + (size_t)j * 5 * 3072; const float* conv_b = p.in[12] + (size_t)j * 3072;
#define PREP2_LOAD(dst, it_) do { const int q_ = (it_) / 12, cs_ = (it_) - q_ * 12; const int col_ = cs_ * 256 + co * 8; \
        _Pragma("unroll") for (int i = 0; i < 12; ++i) { const int l = rg * 8 - 2 + i;     \
            const u16* src = l < 0 ? HALO + (size_t)(q_ * 4 + 2 + l) * 3072 : (l >= 128 ? HALO + (size_t)(q_ * 4 + l - 126) * 3072 : XBC + (size_t)(q_ * 128 + l) * 3072); \
            dst[i] = *(const u32x4*)(src + col_); } } while (0)
    u32x4 in[12], nin[12];
    if ((int)blockIdx.x < 264 * 12) PREP2_LOAD(in, (int)blockIdx.x);
    for (int item = blockIdx.x; item < 264 * 12; item += gridDim.x) {
        const int q = item / 12, cs = item - q * 12; const int col = cs * 256 + co * 8;
        asm volatile("s_waitcnt vmcnt(0)" ::: "memory");
        __syncthreads();
        if (item + (int)gridDim.x < 264 * 12) PREP2_LOAD(nin, item + (int)gridDim.x);
        u32 pk[8][4];
#pragma unroll
        for (int c2 = 0; c2 < 4; ++c2) {
            { const int c = col + 2 * c2; const float w0 = conv_w[c], w1 = conv_w[3072 + c], w2 = conv_w[6144 + c], w3 = conv_w[9216 + c], w4 = conv_w[12288 + c], bb = conv_b[c];
#pragma unroll
              for (int r = 0; r < 8; ++r) pk[r][c2] = (u32)f2bf(silu_f(bb + w0 * bflo(in[r][c2]) + w1 * bflo(in[r + 1][c2]) + w2 * bflo(in[r + 2][c2]) + w3 * bflo(in[r + 3][c2]) + w4 * bflo(in[r + 4][c2]))); }
            { const int c = col + 2 * c2 + 1; const float w0 = conv_w[c], w1 = conv_w[3072 + c], w2 = conv_w[6144 + c], w3 = conv_w[9216 + c], w4 = conv_w[12288 + c], bb = conv_b[c];
#pragma unroll
              for (int r = 0; r < 8; ++r) pk[r][c2] |= (u32)f2bf(silu_f(bb + w0 * bfhi(in[r][c2]) + w1 * bfhi(in[r + 1][c2]) + w2 * bfhi(in[r + 2][c2]) + w3 * bfhi(in[r + 3][c2]) + w4 * bfhi(in[r + 4][c2]))) << 16; }
        }
#pragma unroll
        for (int r = 0; r < 8; ++r) { u32x4 pv; pv[0] = pk[r][0]; pv[1] = pk[r][1]; pv[2] = pk[r][2]; pv[3] = pk[r][3];
            *(u32x4*)(XBC + (size_t)(q * 128 + rg * 8 + r) * 3072 + col) = pv; }
#pragma unroll
        for (int i = 0; i < 12; ++i) in[i] = nin[i];
    }
#undef PREP2_LOAD
}
__device__ __forceinline__ void phase_ssd_cb(const Params& p, unsigned char* lds) {
    const int tid = otid(), wave = __builtin_amdgcn_readfirstlane(tid >> 6), lane = tid & 63, fr = lane & 15, fq = lane >> 4;
    unsigned char* Cs = lds; unsigned char* Bs = lds + 32768;
    const u16* XBC = (const u16*)(p.ws + OFF_XBC); u16* CBG = (u16*)(p.ws + OFF_CBG);
    const int co = tid & 15, rg = tid >> 4;
    for (int item = blockIdx.x; item < 264 * 4; item += gridDim.x) {
        const int q = item >> 2, g = item & 3;
        u32x4 cv[4], bv[4];
#pragma unroll
        for (int r = 0; r < 4; ++r) { const size_t ro = (size_t)(q * 128 + rg * 4 + r) * 3072;
            cv[r] = *(const u32x4*)(XBC + ro + 2560 + g * 128 + co * 8); bv[r] = *(const u32x4*)(XBC + ro + 2048 + g * 128 + co * 8); }
        __syncthreads();
#pragma unroll
        for (int r = 0; r < 4; ++r) { *(u32x4*)(Cs + swz(rg * 4 + r, co * 8)) = cv[r]; *(u32x4*)(Bs + swz(rg * 4 + r, co * 8)) = bv[r]; }
        __syncthreads();
        bf16x8 afrag[4];
#pragma unroll
        for (int kk = 0; kk < 4; ++kk) afrag[kk] = *(const bf16x8*)(Cs + swz(wave * 16 + fr, kk * 32 + fq * 8));
#pragma unroll
        for (int st = 0; st < 8; ++st) {
            f32x4 acc = (f32x4){0.f, 0.f, 0.f, 0.f};
#pragma unroll
            for (int kk = 0; kk < 4; ++kk) { const bf16x8 bfrag = *(const bf16x8*)(Bs + swz(st * 16 + fr, kk * 32 + fq * 8)); acc = __builtin_amdgcn_mfma_f32_16x16x32_bf16(bfrag, afrag[kk], acc, 0, 0, 0); }
            u32x2 o; o[0] = pack2(acc[0], acc[1]); o[1] = pack2(acc[2], acc[3]);
            *(u32x2*)(CBG + (size_t)item * 16384 + (wave * 16 + fr) * 128 + st * 16 + fq * 4) = o;
        }
    }
}
__device__ __forceinline__ void phase_ssd_scan(const Params& p, int j, unsigned char* lds) {
    const int tid0 = otid(), wave = __builtin_amdgcn_readfirstlane(tid0 >> 6);
    unsigned char* Cs = lds; unsigned char* BTs = lds + 32768; unsigned char* Gs = lds + 65536;
    unsigned char* XTs = lds + 98304; unsigned char* Hs = lds + 114688;
    float* cum = (float*)(lds + 131072); float* dtv = cum + 128;
    const u16* XBC = (const u16*)(p.ws + OFF_XBC); const float* DT = (const float*)(p.ws + OFF_DT); const float* CUM = (const float*)(p.ws + OFF_CUM);
    const u16* CBG = (const u16*)(p.ws + OFF_CBG); u16* Y = (u16*)(p.ws + OFF_Y); u16* YC1 = (u16*)(p.ws + OFF_YC1);
    {
        const int it0 = (int)blockIdx.x;
        const int gid = (it0 & 7) + 8 * (it0 >> 6), member = (it0 >> 3) & 7;
        const int d = gid & 1, b = gid >> 3, g = (gid >> 1) & 3, h = g * 8 + member;
        const int xc0 = h * 64, bc0 = 2048 + g * 128, cc0 = 2560 + g * 128, col = d * 32 + h;
        const float Dh = p.in[15][j * 32 + h];
        f32x4 hreg[4];
#pragma unroll
        for (int pt = 0; pt < 4; ++pt) hreg[pt] = (f32x4){0.f, 0.f, 0.f, 0.f};
        __syncthreads();
        *(u32x4*)(Hs + tid0 * 32) = zero4(); *(u32x4*)(Hs + tid0 * 32 + 16) = zero4();
        u32x4 Cr[4], Br[4], Gr[4], Xr[2]; f32x4 cumr, cums0, cums1; float dtl[2], cum128 = 0.f, dt128 = 0.f, tot; u32x2 yold[4];
#define SSD_ROW0(ci) ((ci) < 2 ? ML + b * 256 + (d == 0 ? (ci) : 1 - (ci)) * 128 : b * 8192 + (d == 0 ? (ci) - 2 : 65 - (ci)) * 128)
#define SSD_LOAD(ci, T) do { const int r0_ = SSD_ROW0(ci); const int co_ = (T) & 15, rg_ = (T) >> 4, xo_ = (T) & 7, l_ = (T) >> 3; \
            const float* cb_ = CUM + (size_t)((r0_ >> 7) * 64 + col) * 128; const u16* gb_ = CBG + (size_t)((r0_ >> 7) * 4 + g) * 16384; \
            _Pragma("unroll") for (int r = 0; r < 4; ++r) { const size_t ro_ = (size_t)(r0_ + rg_ * 4 + r); \
                Cr[r] = *(const u32x4*)(XBC + ro_ * 3072 + cc0 + co_ * 8); Br[r] = *(const u32x4*)(XBC + ro_ * 3072 + bc0 + co_ * 8); \
                Gr[r] = *(const u32x4*)(gb_ + (rg_ * 4 + r) * 128 + co_ * 8); } \
            cumr = *(const f32x4*)(cb_ + rg_ * 4); cums0 = *(const f32x4*)(cb_ + co_ * 8); cums1 = *(const f32x4*)(cb_ + co_ * 8 + 4); \
            _Pragma("unroll") for (int i = 0; i < 2; ++i) { Xr[i] = *(const u32x4*)(XBC + (size_t)(r0_ + l_ + 64 * i) * 3072 + xc0 + xo_ * 8); dtl[i] = DT[(size_t)(r0_ + l_ + 64 * i) * 64 + col]; } \
            tot = cb_[d == 0 ? 127 : 0]; \
            if ((T) < 128) { cum128 = cb_[(T)]; dt128 = DT[(size_t)(r0_ + (T)) * 64 + col]; } \
            } while (0)
#define SSD_LOADY(ci, T) do { if ((ci) >= 34) { const int r0_ = SSD_ROW0(ci); const int fr_ = (T) & 15, fq_ = ((T) & 63) >> 4; \
                _Pragma("unroll") for (int pt = 0; pt < 4; ++pt) yold[pt] = *(const u32x2*)(Y + (size_t)(r0_ + wave * 16 + fr_) * 2048 + xc0 + pt * 16 + fq_ * 4); } } while (0)
        SSD_LOAD(0, tid0);
        for (int ci = 0; ci < 66; ++ci) {
            int tid = tid0; asm volatile("" : "+v"(tid));
            if (ci == 34) {
                XcdBarrier xb_; xb_.bar = (unsigned*)(p.ws + OFF_BAR); xb_.x = xb_xcc_id(); xb_.wave = p.wave; xb_.st = (volatile PG8_LAS unsigned*)((PG8_LAS unsigned char*)lds + (LDS_BYTES - 16));
                xcd_barrier(xb_);
                SSD_LOAD(34, tid); SSD_LOADY(34, tid);
            }
            const int lane = tid & 63, fr = lane & 15, fq = lane >> 4;
            const int row0 = SSD_ROW0(ci);
            const float total = tot;
            {
                const int co = tid & 15, rg = tid >> 4;
                float wg[4];
#pragma unroll
                for (int r = 0; r < 4; ++r) { *(u32x4*)(Cs + swz(rg * 4 + r, co * 8)) = Cr[r]; wg[r] = __expf(total - cumr[r]); }
#pragma unroll
                for (int c2 = 0; c2 < 4; ++c2) { u32x2 q0, q1;
                    q0[0] = pack2hw(bflo(Br[0][c2]) * wg[0], bflo(Br[1][c2]) * wg[1]); q0[1] = pack2hw(bflo(Br[2][c2]) * wg[2], bflo(Br[3][c2]) * wg[3]);
                    q1[0] = pack2hw(bfhi(Br[0][c2]) * wg[0], bfhi(Br[1][c2]) * wg[1]); q1[1] = pack2hw(bfhi(Br[2][c2]) * wg[2], bfhi(Br[3][c2]) * wg[3]);
                    *(u32x2*)(BTs + swz(co * 8 + 2 * c2, rg * 4)) = q0; *(u32x2*)(BTs + swz(co * 8 + 2 * c2 + 1, rg * 4)) = q1; }
#pragma unroll
                for (int r = 0; r < 4; ++r) { const int l = rg * 4 + r; const float cl = cumr[r]; u32x4 gv;
#pragma unroll
                    for (int c2 = 0; c2 < 4; ++c2) { const int s0 = co * 8 + 2 * c2;
                        const float cs0 = c2 < 2 ? cums0[2 * c2] : cums1[2 * c2 - 4], cs1 = c2 < 2 ? cums0[2 * c2 + 1] : cums1[2 * c2 - 3];
                        const bool v0 = d == 0 ? (s0 <= l) : (s0 >= l), v1 = d == 0 ? (s0 + 1 <= l) : (s0 + 1 >= l);
                        const float g0 = v0 ? bflo(Gr[r][c2]) * __expf(cl - cs0) : 0.f, g1 = v1 ? bfhi(Gr[r][c2]) * __expf(cl - cs1) : 0.f;
                        gv[c2] = pack2hw(g0, g1); }
                    *(u32x4*)(Gs + swz(l, co * 8)) = gv; }
                const int xo = tid & 7;
#pragma unroll
                for (int i = 0; i < 2; ++i) { const int l = (tid >> 3) + 64 * i;
#pragma unroll
                    for (int c2 = 0; c2 < 4; ++c2) { const u32 pr = pack2hw(bflo(Xr[i][c2]) * dtl[i], bfhi(Xr[i][c2]) * dtl[i]);
                        *(u16*)(XTs + swz(xo * 8 + 2 * c2, l)) = (u16)(pr & 0xFFFFu); *(u16*)(XTs + swz(xo * 8 + 2 * c2 + 1, l)) = (u16)(pr >> 16); } }
                if (tid < 128) { cum[tid] = cum128; dtv[tid] = dt128; }
            }
            if (ci + 1 < 66 && ci + 1 != 34) SSD_LOAD(ci + 1, tid);
            LDS_BARRIER();
            {
                bf16x8 afrag[4], gfrag[4];
#pragma unroll
                for (int kk = 0; kk < 4; ++kk) { afrag[kk] = *(const bf16x8*)(Cs + swz(wave * 16 + fr, kk * 32 + fq * 8)); gfrag[kk] = *(const bf16x8*)(Gs + swz(wave * 16 + fr, kk * 32 + fq * 8)); }
                const int l = wave * 16 + fr;
                const float e = __expf(cum[l]), rdt = Dh / dtv[l];
                u16* yrow = (ci < 2 && d == 1) ? YC1 + (size_t)(row0 - ML + l) * 2048 + xc0 : Y + (size_t)(row0 + l) * 2048 + xc0;
#pragma unroll
                for (int pt = 0; pt < 4; ++pt) {
                    f32x4 accD = (f32x4){0.f, 0.f, 0.f, 0.f}, accO = (f32x4){0.f, 0.f, 0.f, 0.f};
#pragma unroll
                    for (int kk = 0; kk < 4; ++kk) {
                        const bf16x8 xf = *(const bf16x8*)(XTs + swz(pt * 16 + fr, kk * 32 + fq * 8));
                        accD = __builtin_amdgcn_mfma_f32_16x16x32_bf16(xf, gfrag[kk], accD, 0, 0, 0);
                        const bf16x8 hb = *(const bf16x8*)(Hs + swz(pt * 16 + fr, kk * 32 + fq * 8));
                        accO = __builtin_amdgcn_mfma_f32_16x16x32_bf16(hb, afrag[kk], accO, 0, 0, 0);
                    }
                    const int p0 = pt * 16 + fq * 4;
                    float o[4];
                    if (ci >= 34) { const u32x2 yo = yold[pt];
                        o[0] = bflo(yo[0]) + accD[0] + e * accO[0]; o[1] = bfhi(yo[0]) + accD[1] + e * accO[1];
                        o[2] = bflo(yo[1]) + accD[2] + e * accO[2]; o[3] = bfhi(yo[1]) + accD[3] + e * accO[3]; }
                    else { const float dsk = (ci < 2 && d == 1) ? 0.f : rdt;
#pragma unroll
                        for (int jj = 0; jj < 4; ++jj) o[jj] = dsk * bf2f(*(const u16*)(XTs + swz(p0 + jj, l))) + accD[jj] + e * accO[jj]; }
                    u32x2 ov; ov[0] = pack2hw(o[0], o[1]); ov[1] = pack2hw(o[2], o[3]);
                    *(u32x2*)(yrow + p0) = ov;
                }
            }
            {
                if (ci + 1 < 66 && ci + 1 != 34) SSD_LOADY(ci + 1, tid);
                const float et = __expf(total);
                bf16x8 bb[4];
#pragma unroll
                for (int kk = 0; kk < 4; ++kk) bb[kk] = *(const bf16x8*)(BTs + swz(wave * 16 + fr, kk * 32 + fq * 8));
#pragma unroll
                for (int pt = 0; pt < 4; ++pt) {
                    f32x4 acc = hreg[pt] * et;
#pragma unroll
                    for (int kk = 0; kk < 4; ++kk) { const bf16x8 xf = *(const bf16x8*)(XTs + swz(pt * 16 + fr, kk * 32 + fq * 8));
                        acc = __builtin_amdgcn_mfma_f32_16x16x32_bf16(bb[kk], xf, acc, 0, 0, 0); }
                    hreg[pt] = acc;
                }
                LDS_BARRIER();
#pragma unroll
                for (int pt = 0; pt < 4; ++pt) { u32x2 hv; hv[0] = pack2hw(hreg[pt][0], hreg[pt][1]); hv[1] = pack2hw(hreg[pt][2], hreg[pt][3]);
                    *(u32x2*)(Hs + swz(pt * 16 + fr, wave * 16 + fq * 4)) = hv; }
            }
        }
#undef SSD_LOAD
#undef SSD_LOADY
#undef SSD_ROW0
    }
}
__device__ __forceinline__ void phase_ssd_gatenorm(const Params& p, int j) {
    const int lane = otid() & 63, gw = blockIdx.x * 8 + (otid() >> 6), nw = gridDim.x * 8;
    u16* Y = (u16*)(p.ws + OFF_Y); const u16* Z = (const u16*)(p.ws + OFF_Z); const float* ng = p.in[16] + (size_t)j * 2048;
    for (int row = gw; row < MT; row += nw) {
#pragma unroll
        for (int k = 0; k < 4; ++k) {
            const int c = k * 512 + lane * 8;
            const u32x4 yv = *(const u32x4*)(Y + (size_t)row * 2048 + c), zv = *(const u32x4*)(Z + (size_t)row * 2048 + c);
            float yf[8], zf[8], v[8]; unpack8(yv, yf); unpack8(zv, zf);
            if (row >= ML) { const u32x4 y1 = *(const u32x4*)((const u16*)(p.ws + OFF_YC1) + (size_t)(row - ML) * 2048 + c); float y1f[8]; unpack8(y1, y1f);
#pragma unroll
                for (int i = 0; i < 8; ++i) yf[i] += y1f[i]; }
            float ss = 0.f;
#pragma unroll
            for (int i = 0; i < 8; ++i) { v[i] = yf[i] * silu_f(zf[i]); ss += v[i] * v[i]; }
            ss = wave_sum(ss);
            const float rstd = rsqrtf(ss * (1.f / 512.f) + 1e-6f);
            const float4 g0 = *(const float4*)(ng + c), g1 = *(const float4*)(ng + c + 4);
            u32x4 o;
            o[0] = pack2(v[0] * rstd * g0.x, v[1] * rstd * g0.y); o[1] = pack2(v[2] * rstd * g0.z, v[3] * rstd * g0.w);
            o[2] = pack2(v[4] * rstd * g1.x, v[5] * rstd * g1.y); o[3] = pack2(v[6] * rstd * g1.z, v[7] * rstd * g1.w);
            *(u32x4*)(Y + (size_t)row * 2048 + c) = o;
        }
    }
}

template <int W> __device__ __forceinline__ void pool_lat_item(const u16* U, u16* PO, float* cs, size_t base, int r, int g, int cp, int cq) {
    const int HW = 1 << g;
#pragma unroll 2
    for (int ci = 0; ci < 16; ++ci) { const int c = cq + 4 * ci;
        u32 v[W];
#pragma unroll
        for (int k = 0; k < W; ++k) { const int rr = min(max(r - HW + k, 0), 127); v[k] = *(const u32*)(U + (base + rr * 64 + c) * 1024 + g * 256 + 2 * cp); }
        float s0 = 0.f, s1 = 0.f;
#pragma unroll
        for (int k = 0; k < W; ++k) { const int rr = r - HW + k; const float wt = (k < 2 * HW && rr >= 0 && rr < 128) ? 1.f : 0.f; s0 += wt * bflo(v[k]); s1 += wt * bfhi(v[k]); }
        cs[c * 256 + 2 * cp] = s0; cs[c * 256 + 2 * cp + 1] = s1; }
    __syncthreads();
    const int cnt_r = min(r + HW, 128) - max(r - HW, 0);
#pragma unroll 2
    for (int ci = 0; ci < 16; ++ci) { const int c = cq + 4 * ci;
        float s0 = 0.f, s1 = 0.f;
#pragma unroll
        for (int k = 0; k < W; ++k) { const int c2 = c - HW + k; const int cc = min(max(c2, 0), 63); const float wt = (k < 2 * HW && c2 >= 0 && c2 < 64) ? 1.f : 0.f;
            s0 += wt * cs[cc * 256 + 2 * cp]; s1 += wt * cs[cc * 256 + 2 * cp + 1]; }
        const int cnt_c = min(c + HW, 64) - max(c - HW, 0);
        const float inv = 1.f / ((float)cnt_r * (float)cnt_c);
        const size_t row = base + r * 64 + c;
        const u32 tk = *(const u32*)(U + row * 1024 + g * 256 + 2 * cp);
        *(u32*)(PO + row * 1024 + g * 256 + 2 * cp) = pack2(s0 * inv - bflo(tk), s1 * inv - bfhi(tk)); }
}
template <int W> __device__ __forceinline__ void pool_ctx_item(const u16* U, u16* PO, size_t base, int g, int cp, int cq, int sub) {
    const int HW = 1 << g;
#pragma unroll 2
    for (int i = 4 * sub; i < 4 * sub + 4; ++i) { const int t = cq + 4 * i;
        u32 v[W];
#pragma unroll
        for (int k = 0; k < W; ++k) { const int sidx = min(max(t - HW + k, 0), 255); v[k] = *(const u32*)(U + (base + sidx) * 1024 + g * 256 + 2 * cp); }
        float s0 = 0.f, s1 = 0.f;
#pragma unroll
        for (int k = 0; k < W; ++k) { const int sidx = t - HW + k; const float wt = (k < 2 * HW && sidx >= 0 && sidx < 256) ? 1.f : 0.f; s0 += wt * bflo(v[k]); s1 += wt * bfhi(v[k]); }
        const float inv = 1.f / (float)(min(t + HW, 256) - max(t - HW, 0));
        const u32 tk = *(const u32*)(U + (base + t) * 1024 + g * 256 + 2 * cp);
        *(u32*)(PO + (base + t) * 1024 + g * 256 + 2 * cp) = pack2(s0 * inv - bflo(tk), s1 * inv - bfhi(tk)); }
}
__device__ __forceinline__ void phase_pool(const Params& p, unsigned char* lds) {
    float* cs = (float*)lds;
    const int tid = otid(), cp = tid & 127, cq = tid >> 7;
    const u16* U = (const u16*)(p.ws + OFF_U); u16* PO = (u16*)(p.ws + OFF_POOLED);
    for (int item = blockIdx.x; item < 2048 + 256; item += gridDim.x) {
        __syncthreads();
        if (item < 2048) {
            const int b = item >> 9, r = (item >> 2) & 127, g = item & 3;
            const size_t base = (size_t)b * 8192;
            if (g < 2) pool_lat_item<4>(U, PO, cs, base, r, g, cp, cq);
            else pool_lat_item<16>(U, PO, cs, base, r, g, cp, cq);
        } else {
            const int it = item - 2048, bg = it >> 4, sub = it & 15, b = bg >> 2, g = bg & 3;
            const size_t base = (size_t)ML + b * 256;
            pool_ctx_item<16>(U, PO, base, g, cp, cq, sub);
        }
    }
}

__device__ __forceinline__ float2 cmul(float2 a, float2 b) { return make_float2(a.x * b.x - a.y * b.y, a.x * b.y + a.y * b.x); }
__device__ __forceinline__ float2 twid(float turns) { return make_float2(__builtin_amdgcn_cosf(turns), __builtin_amdgcn_sinf(turns)); }
__device__ __forceinline__ void fft_fwd(const Params& p, float2* X) {
    const int tid = otid();
    for (int s = 8192; s >= 2; s >>= 2) {
        const int q = s >> 1, lq = __builtin_ctz(q); const float inv2s = 0.5f / (float)s, invs = 1.0f / (float)s;
#pragma unroll 4
        for (int it = 0; it < 8; ++it) {
            const int jx = tid + it * 512; const int grp = jx >> lq, pos = jx & (q - 1); const int i0 = grp * 2 * s + pos;
            const float2 a = X[i0], b = X[i0 + q], c = X[i0 + s], dd = X[i0 + s + q];
            const float2 tw = twid((float)pos * inv2s);
            const float2 w1 = make_float2(tw.x, -tw.y), w2 = make_float2(-tw.y, -tw.x), w3 = make_float2(tw.x * tw.x - tw.y * tw.y, -2.f * tw.x * tw.y);
            const float2 a1 = make_float2(a.x + c.x, a.y + c.y), c1 = cmul(make_float2(a.x - c.x, a.y - c.y), w1);
            const float2 b1 = make_float2(b.x + dd.x, b.y + dd.y), d1 = cmul(make_float2(b.x - dd.x, b.y - dd.y), w2);
            X[i0] = make_float2(a1.x + b1.x, a1.y + b1.y); X[i0 + q] = cmul(make_float2(a1.x - b1.x, a1.y - b1.y), w3);
            X[i0 + s] = make_float2(c1.x + d1.x, c1.y + d1.y); X[i0 + s + q] = cmul(make_float2(c1.x - d1.x, c1.y - d1.y), w3);
        }
        __syncthreads();
    }
}
__device__ __forceinline__ void fft_inv(const Params& p, float2* X) {
    const int tid = otid();
    for (int s = 2; s <= 8192; s <<= 2) {
        const int q = s >> 1, lq = __builtin_ctz(q); const float inv2s = 0.5f / (float)s, invs = 1.0f / (float)s;
#pragma unroll 4
        for (int it = 0; it < 8; ++it) {
            const int jx = tid + it * 512; const int grp = jx >> lq, pos = jx & (q - 1); const int i0 = grp * 2 * s + pos;
            const float2 a = X[i0], b = X[i0 + q], c = X[i0 + s], dd = X[i0 + s + q];
            const float2 w1 = twid((float)pos * inv2s), w2 = make_float2(-w1.y, w1.x), w3 = make_float2(w1.x * w1.x - w1.y * w1.y, 2.f * w1.x * w1.y);
            const float2 bw = cmul(b, w3), dw = cmul(dd, w3);
            const float2 a1 = make_float2(a.x + bw.x, a.y + bw.y), b1 = make_float2(a.x - bw.x, a.y - bw.y);
            const float2 c1 = make_float2(c.x + dw.x, c.y + dw.y), d1 = make_float2(c.x - dw.x, c.y - dw.y);
            const float2 cw = cmul(c1, w1), dw2 = cmul(d1, w2);
            X[i0] = make_float2(a1.x + cw.x, a1.y + cw.y); X[i0 + s] = make_float2(a1.x - cw.x, a1.y - cw.y);
            X[i0 + q] = make_float2(b1.x + dw2.x, b1.y + dw2.y); X[i0 + s + q] = make_float2(b1.x - dw2.x, b1.y - dw2.y);
        }
        __syncthreads();
    }
}
__device__ __forceinline__ int brev14(int k) { return (int)(__brev((unsigned)k) >> 18); }
__device__ __forceinline__ void spec_mul(const Params& p, float2* X, const float2* Ka, const float2* Kb) {
    const int tid = otid();
#pragma unroll 1
    for (int half = 0; half < 2; ++half) {
        float2 ka[8], kb[8];
#pragma unroll
        for (int i = 0; i < 8; ++i) { const int k = tid + 512 * (half * 8 + i); ka[i] = Ka[k]; kb[i] = Kb[k]; }
#pragma unroll
        for (int i = 0; i < 8; ++i) { const int k = tid + 512 * (half * 8 + i);
            const int pk = brev14(k), pm = brev14((16384 - k) & 16383);
            const float2 zk = X[pk], zm = X[pm];
            const float2 ua = make_float2(0.5f * (zk.x + zm.x), 0.5f * (zk.y - zm.y));
            const float2 ub = make_float2(0.5f * (zk.y + zm.y), -0.5f * (zk.x - zm.x));
            const float2 pa = cmul(ua, ka[i]), pb = cmul(ub, kb[i]);
            X[pk] = make_float2(pa.x - pb.y, pa.y + pb.x);
            X[pm] = make_float2(pa.x + pb.y, -pa.y + pb.x); }
    }
    if (tid == 0) { const int pk = brev14(8192);
        const float2 zk = X[pk];
        const float2 pa = cmul(make_float2(zk.x, 0.f), Ka[8192]), pb = cmul(make_float2(zk.y, 0.f), Kb[8192]);
        X[pk] = make_float2(pa.x - pb.y, pa.y + pb.x); }
    __syncthreads();
}
__device__ __forceinline__ void conv3x4(const u16* rowp, int n0, float w0, float w1, float w2, float bias, float (&out)[4]) {
    const u32x2 v = *(const u32x2*)(rowp + n0);
    const float c0 = bflo(v[0]), c1 = bfhi(v[0]), c2 = bflo(v[1]), c3 = bfhi(v[1]);
    const float l = n0 > 0 ? bf2f(rowp[n0 - 1]) : 0.f; const float r = n0 + 4 < 8192 ? bf2f(rowp[n0 + 4]) : 0.f;
    out[0] = bias + w0 * l + w1 * c0 + w2 * c1; out[1] = bias + w0 * c0 + w1 * c1 + w2 * c2;
    out[2] = bias + w0 * c1 + w1 * c2 + w2 * c3; out[3] = bias + w0 * c2 + w1 * c3 + w2 * r;
}
__device__ __forceinline__ float conv3_at(const u16* rowp, int n, int L, float w0, float w1, float w2, float bias) {
    const float c = bf2f(rowp[n]); const float l = n > 0 ? bf2f(rowp[n - 1]) : 0.f; const float r = n < L - 1 ? bf2f(rowp[n + 1]) : 0.f;
    return bias + w0 * l + w1 * c + w2 * r;
}
__device__ __forceinline__ void phase_hyena_lat(const Params& p, unsigned char* lds) {
    float2* X = (float2*)lds; float* aux = (float*)(lds + 131072);
    float* w3s = aux; float* red = aux + 512;
    const int tid = otid(), lane = tid & 63, wave = tid >> 6;
    const u16* PT = (const u16*)(p.ws + OFF_PT); u16* YT = (u16*)(p.ws + OFF_YT);
    float2* KF = (float2*)(p.ws + OFF_KF) + (size_t)blockIdx.x * 4 * KF_STRIDE;
    float2* ZS = (float2*)(p.ws + OFF_ZS) + (size_t)blockIdx.x * 8192;
    const float* HID2 = (const float*)(p.ws + OFF_HID2); const float* fw3 = p.in[28];
    for (int pair = blockIdx.x; pair < 512; pair += gridDim.x) {
        const int cha = 2 * pair;
        {
            float2* K1 = KF + (size_t)2 * KF_STRIDE;
            __syncthreads();
            { const int o = tid >> 8, which = (tid >> 6) & 3, jj = tid & 63; const int ch = cha + (which >> 1), dir = which & 1;
              w3s[tid] = fw3[(size_t)jj * 4096 + (o * 2 + dir) * 1024 + ch]; }
            __syncthreads();
            const float dela = 3.0701134573253945f + (float)cha * (12.280453829301578f / 1023.f);
            const float delb = 3.0701134573253945f + (float)(cha + 1) * (12.280453829301578f / 1023.f);
            float ss0a = 0.f, ss0b = 0.f, ss1a = 0.f, ss1b = 0.f;
#pragma unroll 1
            for (int i = 0; i < 16; ++i) {
                const int pos = tid + 512 * i;
                const float4* hr = (const float4*)(HID2 + (size_t)pos * 64);
                float d[8]; float4 hv[16];
#pragma unroll
                for (int q4 = 0; q4 < 16; ++q4) hv[q4] = hr[q4];
#pragma unroll
                for (int c = 0; c < 8; ++c) { float acc = 0.f; const float* wc = w3s + c * 64;
#pragma unroll
                    for (int q4 = 0; q4 < 16; ++q4) acc += hv[q4].x * wc[q4 * 4] + hv[q4].y * wc[q4 * 4 + 1] + hv[q4].z * wc[q4 * 4 + 2] + hv[q4].w * wc[q4 * 4 + 3];
                    asm volatile("" : "+v"(acc));
                    d[c] = acc; }
                const float t = (float)pos / 8191.f; const float ea = __expf(-t * dela), eb = __expf(-t * delb);
                const float h0a = d[0] * ea, h1a = d[1] * ea, h0b = d[2] * eb, h1b = d[3] * eb;
                const float g0a = d[4] * ea, g1a = d[5] * ea, g0b = d[6] * eb, g1b = d[7] * eb;
                ss0a += h0a * h0a + h1a * h1a; ss0b += h0b * h0b + h1b * h1b; ss1a += g0a * g0a + g1a * g1a; ss1b += g0b * g0b + g1b * g1b;
                X[pos] = make_float2(h0a, h0b); K1[pos] = make_float2(g0a, g0b);
                if (pos >= 1) { X[16384 - pos] = make_float2(h1a, h1b); K1[16384 - pos] = make_float2(g1a, g1b); }
            }
            if (tid == 0) { const float4 z4 = zerof4(); X[8192] = make_float2(z4.x, z4.y); K1[8192] = make_float2(z4.x, z4.y); }
            ss0a = wave_sum(ss0a); ss0b = wave_sum(ss0b); ss1a = wave_sum(ss1a); ss1b = wave_sum(ss1b);
            if (lane == 0) { red[wave] = ss0a; red[8 + wave] = ss0b; red[16 + wave] = ss1a; red[24 + wave] = ss1b; }
            __syncthreads();
#pragma unroll 1
            for (int o = 0; o < 2; ++o) {
                float ta = 0.f, tb = 0.f;
#pragma unroll
                for (int w = 0; w < 8; ++w) { ta += red[o * 16 + w]; tb += red[o * 16 + 8 + w]; }
                const float sa = rsqrtf(ta + 1e-6f), sb = rsqrtf(tb + 1e-6f);
                if (o == 1) {
                    __syncthreads();
                    float4* X4 = (float4*)X; const float4* K4 = (const float4*)(KF + (size_t)2 * KF_STRIDE);
#pragma unroll
                    for (int i = 0; i < 16; ++i) X4[tid + 512 * i] = K4[tid + 512 * i];
                    __syncthreads();
                }
                fft_fwd(p, X);
                float2* Ka = KF + (size_t)(o * 2) * KF_STRIDE; float2* Kb = Ka + KF_STRIDE;
                for (int k = tid; k <= 8192; k += 512) {
                    const int pk = brev14(k), pm = brev14((16384 - k) & 16383);
                    const float2 zk = X[pk], zm = X[pm];
                    Ka[k] = make_float2(sa * 0.5f * (zk.x + zm.x), sa * 0.5f * (zk.y - zm.y));
                    Kb[k] = make_float2(sb * 0.5f * (zk.y + zm.y), -sb * 0.5f * (zk.x - zm.x));
                }
            }
        }
        __threadfence_block();
        __syncthreads();
        const float* cw = p.in[22]; const float* cb = p.in[23]; const float* hbias = p.in[30];
        int tidc = tid; asm volatile("" : "+v"(tidc));
        float wv[2][3][4];
#pragma unroll
        for (int ab = 0; ab < 2; ++ab)
#pragma unroll
            for (int part = 0; part < 3; ++part) { const int cidx = part * 1024 + cha + ab;
                wv[ab][part][0] = cw[cidx]; wv[ab][part][1] = cw[3072 + cidx]; wv[ab][part][2] = cw[6144 + cidx]; wv[ab][part][3] = cb[cidx]; }
        const float hb0a = hbias[cha], hb0b = hbias[cha + 1], hb1a = hbias[1024 + cha], hb1b = hbias[1024 + cha + 1];
        for (int b = 0; b < 4; ++b) {
            const u16* va = PT + (size_t)cha * MT + (size_t)b * 8192; const u16* vb = va + MT;
            const u16* x1a = va + (size_t)1024 * MT; const u16* x1b = x1a + MT;
            const u16* x2a = va + (size_t)2048 * MT; const u16* x2b = x2a + MT;
            __syncthreads();
            float4* X4 = (float4*)X; float4* ZS4 = (float4*)ZS;
#pragma unroll
            for (int g = 0; g < 4; ++g) { const int n0 = 4 * (tidc + 512 * g);
                float a[4], c[4];
                conv3x4(va, n0, wv[0][0][0], wv[0][0][1], wv[0][0][2], wv[0][0][3], a); conv3x4(vb, n0, wv[1][0][0], wv[1][0][1], wv[1][0][2], wv[1][0][3], c);
                X4[n0 >> 1] = make_float4(a[0], c[0], a[1], c[1]); X4[(n0 >> 1) + 1] = make_float4(a[2], c[2], a[3], c[3]);
                X4[4096 + (n0 >> 1)] = zerof4(); X4[4096 + (n0 >> 1) + 1] = zerof4(); }
            __syncthreads();
            fft_fwd(p, X);
            spec_mul(p, X, KF, KF + KF_STRIDE);
            fft_inv(p, X);
#pragma unroll
            for (int g = 0; g < 4; ++g) { const int n0 = 4 * (tidc + 512 * g);
                float a[4], c[4], xa[4], xb[4];
                conv3x4(va, n0, wv[0][0][0], wv[0][0][1], wv[0][0][2], wv[0][0][3], a); conv3x4(vb, n0, wv[1][0][0], wv[1][0][1], wv[1][0][2], wv[1][0][3], c);
                conv3x4(x1a, n0, wv[0][1][0], wv[0][1][1], wv[0][1][2], wv[0][1][3], xa); conv3x4(x1b, n0, wv[1][1][0], wv[1][1][1], wv[1][1][2], wv[1][1][3], xb);
                const float4 q0 = X4[n0 >> 1], q1 = X4[(n0 >> 1) + 1];
                const float4 z0 = make_float4(xa[0] * (q0.x * (1.f / 16384.f) + a[0] * hb0a), xb[0] * (q0.y * (1.f / 16384.f) + c[0] * hb0b),
                                              xa[1] * (q0.z * (1.f / 16384.f) + a[1] * hb0a), xb[1] * (q0.w * (1.f / 16384.f) + c[1] * hb0b));
                const float4 z1 = make_float4(xa[2] * (q1.x * (1.f / 16384.f) + a[2] * hb0a), xb[2] * (q1.y * (1.f / 16384.f) + c[2] * hb0b),
                                              xa[3] * (q1.z * (1.f / 16384.f) + a[3] * hb0a), xb[3] * (q1.w * (1.f / 16384.f) + c[3] * hb0b));
                ZS4[n0 >> 1] = z0; ZS4[(n0 >> 1) + 1] = z1; X4[n0 >> 1] = z0; X4[(n0 >> 1) + 1] = z1;
                X4[4096 + (n0 >> 1)] = zerof4(); X4[4096 + (n0 >> 1) + 1] = zerof4(); }
            __syncthreads();
            fft_fwd(p, X);
            spec_mul(p, X, KF + 2 * KF_STRIDE, KF + 3 * KF_STRIDE);
            fft_inv(p, X);
#pragma unroll
            for (int g = 0; g < 4; ++g) { const int n0 = 4 * (tidc + 512 * g);
                float xa[4], xb[4];
                conv3x4(x2a, n0, wv[0][2][0], wv[0][2][1], wv[0][2][2], wv[0][2][3], xa); conv3x4(x2b, n0, wv[1][2][0], wv[1][2][1], wv[1][2][2], wv[1][2][3], xb);
                const float4 q0 = X4[n0 >> 1], q1 = X4[(n0 >> 1) + 1]; const float4 z0 = ZS4[n0 >> 1], z1 = ZS4[(n0 >> 1) + 1];
                u32x2 oa, ob;
                oa[0] = pack2(xa[0] * (q0.x * (1.f / 16384.f) + z0.x * hb1a), xa[1] * (q0.z * (1.f / 16384.f) + z0.z * hb1a));
                oa[1] = pack2(xa[2] * (q1.x * (1.f / 16384.f) + z1.x * hb1a), xa[3] * (q1.z * (1.f / 16384.f) + z1.z * hb1a));
                ob[0] = pack2(xb[0] * (q0.y * (1.f / 16384.f) + z0.y * hb1b), xb[1] * (q0.w * (1.f / 16384.f) + z0.w * hb1b));
                ob[1] = pack2(xb[2] * (q1.y * (1.f / 16384.f) + z1.y * hb1b), xb[3] * (q1.w * (1.f / 16384.f) + z1.w * hb1b));
                *(u32x2*)(YT + (size_t)cha * MT + (size_t)b * 8192 + n0) = oa;
                *(u32x2*)(YT + (size_t)(cha + 1) * MT + (size_t)b * 8192 + n0) = ob; }
        }
    }
}
__device__ __forceinline__ void phase_hyena_ctx(const Params& p, unsigned char* lds) {
    float* kf = (float*)lds;
    float* vs = kf + 1024; float* x1s = vs + 1024; float* x2s = x1s + 1024; float* zs = x2s + 1024; float* red = zs + 1024;
    const int tid = otid(), lane = tid & 63, wave = tid >> 6;
    const u16* PT = (const u16*)(p.ws + OFF_PT); u16* YT = (u16*)(p.ws + OFF_YT);
    const float* HID2C = (const float*)(p.ws + OFF_HID2C); const float* fw3 = p.in[28];
    const float* cw = p.in[22]; const float* cb = p.in[23]; const float* hbias = p.in[30];
    for (int ch = blockIdx.x; ch < 1024; ch += gridDim.x) {
        __syncthreads();
        {
            const int pos = tid & 255, o = tid >> 8;
            float* w3c = red + 16;
            if (tid < 256) w3c[tid] = fw3[(size_t)(tid & 63) * 4096 + (tid >> 6) * 1024 + ch];
            float4 hrow[16];
#pragma unroll
            for (int q4 = 0; q4 < 16; ++q4) hrow[q4] = *(const float4*)(HID2C + (size_t)pos * 64 + q4 * 4);
            __syncthreads();
            float d0 = 0.f, d1 = 0.f;
#pragma unroll
            for (int q4 = 0; q4 < 16; ++q4) { const float* wa = w3c + (o * 2) * 64 + q4 * 4; const float* wb = wa + 64;
                d0 += hrow[q4].x * wa[0] + hrow[q4].y * wa[1] + hrow[q4].z * wa[2] + hrow[q4].w * wa[3];
                d1 += hrow[q4].x * wb[0] + hrow[q4].y * wb[1] + hrow[q4].z * wb[2] + hrow[q4].w * wb[3]; }
            const float del = 3.0701134573253945f + (float)ch * (12.280453829301578f / 1023.f);
            const float e = __expf(-((float)pos / 255.f) * del);
            const float h0 = d0 * e, h1 = d1 * e;
            float ss = wave_sum(h0 * h0 + h1 * h1);
            if (lane == 0) red[wave] = ss;
            __syncthreads();
            const float tot = red[o * 4] + red[o * 4 + 1] + red[o * 4 + 2] + red[o * 4 + 3];
            const float sc = rsqrtf(tot + 1e-6f);
            kf[(o * 2) * 256 + pos] = h0 * sc; kf[(o * 2 + 1) * 256 + pos] = h1 * sc;
        }
        const float w00 = cw[ch], w01 = cw[3072 + ch], w02 = cw[6144 + ch], b0 = cb[ch];
        const float w10 = cw[1024 + ch], w11 = cw[3072 + 1024 + ch], w12 = cw[6144 + 1024 + ch], b1 = cb[1024 + ch];
        const float w20 = cw[2048 + ch], w21 = cw[3072 + 2048 + ch], w22 = cw[6144 + 2048 + ch], b2 = cb[2048 + ch];
        const float hb0 = hbias[ch], hb1 = hbias[1024 + ch];
#pragma unroll
        for (int r = 0; r < 2; ++r) { const int idx = tid + 512 * r, bb = idx >> 8, l = idx & 255;
            const u16* base = PT + (size_t)ch * MT + ML + bb * 256;
            vs[idx] = conv3_at(base, l, 256, w00, w01, w02, b0);
            x1s[idx] = conv3_at(base + (size_t)1024 * MT, l, 256, w10, w11, w12, b1);
            x2s[idx] = conv3_at(base + (size_t)2048 * MT, l, 256, w20, w21, w22, b2); }
        __syncthreads();
#pragma unroll
        for (int r = 0; r < 2; ++r) { const int idx = tid + 512 * r, bb = idx >> 8, l = idx & 255;
            float c = 0.f;
            for (int s = 0; s <= l; ++s) c += kf[l - s] * vs[bb * 256 + s];
            for (int s = l + 1; s < 256; ++s) c += kf[256 + s - l] * vs[bb * 256 + s];
            zs[idx] = x1s[idx] * (c + vs[idx] * hb0); }
        __syncthreads();
#pragma unroll
        for (int r = 0; r < 2; ++r) { const int idx = tid + 512 * r, bb = idx >> 8, l = idx & 255;
            float c = 0.f;
            for (int s = 0; s <= l; ++s) c += kf[512 + l - s] * zs[bb * 256 + s];
            for (int s = l + 1; s < 256; ++s) c += kf[768 + s - l] * zs[bb * 256 + s];
            YT[(size_t)ch * MT + ML + idx] = f2bf(x2s[idx] * (c + zs[idx] * hb1)); }
    }
}
__device__ __forceinline__ void phase_transpose_y(const Params& p, unsigned char* lds) {
    u16* tile = (u16*)lds;
    const int tid = otid();
    const u16* YT = (const u16*)(p.ws + OFF_YT); u16* Yh = (u16*)(p.ws + OFF_U);
    u32 v[4], nv[4];
    int t = blockIdx.x;
    if (t < 16 * 528) { const int c0 = (t / 528) << 6, r0 = (t % 528) << 6;
#pragma unroll
        for (int r = 0; r < 4; ++r) v[r] = *(const u32*)(YT + (size_t)(c0 + (tid >> 5) + 16 * r) * MT + r0 + (tid & 31) * 2); }
    for (; t < 16 * 528; t += gridDim.x) {
        const int c0 = (t / 528) << 6, r0 = (t % 528) << 6;
        const int tn = t + (int)gridDim.x;
        if (tn < 16 * 528) { const int c1 = (tn / 528) << 6, r1 = (tn % 528) << 6;
#pragma unroll
            for (int r = 0; r < 4; ++r) nv[r] = *(const u32*)(YT + (size_t)(c1 + (tid >> 5) + 16 * r) * MT + r1 + (tid & 31) * 2); }
        LDS_BARRIER();
#pragma unroll
        for (int r = 0; r < 4; ++r) { const int i = (tid >> 5) + 16 * r, j2 = (tid & 31) * 2; tile[i * 66 + j2] = (u16)(v[r] & 0xFFFFu); tile[i * 66 + j2 + 1] = (u16)(v[r] >> 16); }
        LDS_BARRIER();
#pragma unroll
        for (int r = 0; r < 4; ++r) { const int jt = (tid >> 5) + 16 * r, c2 = (tid & 31) * 2;
            *(u32*)(Yh + (size_t)(r0 + jt) * 1024 + c0 + c2) = (u32)tile[c2 * 66 + jt] | ((u32)tile[(c2 + 1) * 66 + jt] << 16); }
#pragma unroll
        for (int r = 0; r < 4; ++r) v[r] = nv[r];
    }
}

__global__ void __launch_bounds__(512, 2) hybrid_fwd(KArgs ka) {
    extern __shared__ __attribute__((aligned(16))) unsigned char shm[];
    cg::grid_group grid = cg::this_grid();
    Params p; p.in = (const float* const*)(ka.ws + OFF_TAB); p.out = ka.out; p.ws = ka.ws; p.wave = __builtin_amdgcn_readfirstlane((int)threadIdx.x >> 6);
    volatile PG8_LAS unsigned* st = (volatile PG8_LAS unsigned*)((PG8_LAS unsigned char*)shm + (LDS_BYTES - 16));
    if (threadIdx.x == 0) { st[0] = 0u; st[1] = 0u; }
    __syncthreads();
    (void)xcd_barrier_post((unsigned*)(p.ws + OFF_BAR), st);
#if PROBE
    unsigned long long* TS = (unsigned long long*)(p.ws + OFF_TS); int nsync = 0;
#define STAMP() do { if (blockIdx.x == 0 && threadIdx.x == 0) TS[nsync] = wall_clock64(); ++nsync; } while (0)
#else
#define STAMP() do { } while (0)
#endif
#define SYNC() do { XcdBarrier xb_; xb_.bar = (unsigned*)(p.ws + OFF_BAR); xb_.x = xb_xcc_id(); xb_.wave = p.wave; xb_.st = (volatile PG8_LAS unsigned*)((PG8_LAS unsigned char*)shm + (LDS_BYTES - 16)); xcd_barrier(xb_); STAMP(); asm volatile("" : "+s"(p.ws), "+s"(p.out), "+s"(p.in)); } while (0)
    u16* U = (u16*)(p.ws + OFF_U);
    float* Hc = (float*)(p.ws + OFF_HC);
    phase_setup(ka, shm, p.wave);
    grid.sync();
    STAMP();
    phase_modreduce(p);
    SYNC();
    int prev_nslice = 0;
#pragma unroll 1
    for (int layer = 0; layer < 4; ++layer) {
        const int kind = layer % 3, j = layer / 3;
        const float* modl = (const float*)(p.ws + OFF_MOD) + (size_t)layer * 5 * 9216;
#pragma unroll 1
        for (int sub = 0; sub < 3; ++sub) {
            if (sub == 0) convert_layer(p, layer, shm);
            const bool first = layer == 0 && sub == 0;
            phase_modulate(p, layer, sub, prev_nslice, first);
            SYNC();
            const u16* RA; const u16* RB; int RK; const float* rbias = (const float*)(p.ws + OFF_CONST); const float* rscale = rbias + 1024; float gmul;
            if (sub != 1) {
                const int f = sub == 0 ? 0 : 1;
                EpiFFN1 e1; e1.H = (u16*)(p.ws + OFF_HID);
                run_gemm(p.wave, shm, U, (const u16*)(p.ws + (f ? OFF_WGU1 : OFF_WGU0)), (layer == 3 && sub == 2) ? ML : MT, 5632, 1024, e1);
                SYNC();
                RA = (const u16*)(p.ws + OFF_HID); RB = (const u16*)(p.ws + (f ? OFF_WD1 : OFF_WD0)); RK = FF; gmul = 0.5f;
            } else {
                gmul = 1.0f;
                if (kind == 0) {
                    EpiSSDin es; es.Z = (u16*)(p.ws + OFF_Z); es.XBC = (u16*)(p.ws + OFF_XBC); es.DT = (float*)(p.ws + OFF_DT);
                    run_gemm(p.wave, shm, U, (const u16*)(p.ws + OFF_WM1), MT, 5376, 1024, es);
                    SYNC();
                    phase_ssd_prep1(p, j);
                    SYNC();
                    phase_ssd_prep2(p, j);
                    SYNC();
                    phase_ssd_cb(p, shm);
                    SYNC();
                    phase_ssd_scan(p, j, shm);
#if DBL_SCAN
                    if (layer == 0) phase_ssd_scan(p, j, shm);
#endif
                    SYNC();
                    phase_ssd_gatenorm(p, j);
                    SYNC();
                    RA = (const u16*)(p.ws + OFF_Y); RB = (const u16*)(p.ws + OFF_WM2); RK = 2048;
                } else if (kind == 1) {
                    phase_pool(p, shm);
                    SYNC();
                    RA = (const u16*)(p.ws + OFF_POOLED); RB = (const u16*)(p.ws + OFF_WM1); RK = 1024; rbias = p.in[19]; rscale = p.in[20];
                } else {
                    EpiBf16T et; et.O = (u16*)(p.ws + OFF_PT); et.ldc = MT;
                    run_gemm(p.wave, shm, (const u16*)(p.ws + OFF_WM1), U, 3072, MT, 1024, et);
                    SYNC();
                    phase_hyena_lat(p, shm);
#if DBL_HY
                    phase_hyena_lat(p, shm);
#endif
                    phase_hyena_ctx(p, shm);
                    SYNC();
                    phase_transpose_y(p, shm);
                    SYNC();
                    RA = U; RB = (const u16*)(p.ws + OFF_WM2); RK = 1024;
                }
            }
            {
                const bool ctx_live = !(layer == 3 && sub >= 1);
                const int nslice = RK >> 8, piece = (int)blockIdx.x;
                OneUnit os; os.has = ctx_live && piece < 16 * nslice;
                const int unit = os.has ? piece / nslice : 0, slice = os.has ? piece - unit * nslice : 0;
                os.u.pm = 128 + (unit >> 2); os.u.pn = unit & 3;
                const float* zeros = (const float*)(p.ws + OFF_CONST);
                const EpiResidPart ea{(float*)(p.ws + OFF_CPART) + (size_t)slice * 1024 * 1024, modl + (3 * sub + 2) * 1024, slice == 0 ? rbias : zeros, rscale, gmul, 0.f};
                Gemm g; g.A = RA + slice * 256; g.Bt = RB + slice * 256; g.M = MT; g.N = 1024; g.K = 256; g.ld = RK; g.wave = p.wave;
                gemm_phase<EpiResidPart, OneUnit>((PG8_LAS unsigned char*)shm, g, os, ea);
                prev_nslice = ctx_live ? nslice : 0;
            }
            const EpiResid er{p.out, first ? p.in[0] : (const float*)p.out, modl + (3 * sub + 2) * 1024, rbias, rscale, gmul, 0.f};
            run_gemm(p.wave, shm, RA, RB, ML, 1024, RK, er);
            SYNC();
        }
    }
    phase_final(p);
#if PROBE
    SYNC();
    if (blockIdx.x == 0) {
        const float t1 = (float)(TS[PROBE_P1] - TS[PROBE_P1 - 1]) * 0.01f, t2 = (float)(TS[PROBE_P2] - TS[PROBE_P2 - 1]) * 0.01f;
        if (threadIdx.x == 0) p.out[0] = 32.f * t1;
        for (int i = threadIdx.x; i < (1 << 20); i += 512) p.out[(1 << 20) + i] += t2;
    }
#endif
}

extern "C" void kernel_launch(void* const* d_in, const int* in_sizes, int n_in, void* d_out, int out_size, void* d_ws, size_t ws_size, hipStream_t stream) {
    static int grid_blocks = 0;
    if (grid_blocks == 0) {
        if (n_in != 33 || out_size != ML * 1024 || ws_size < WS_END) { fprintf(stderr, "kernel_launch: unexpected problem (n_in %d, out %d, ws %zu < %zu)\n", n_in, out_size, ws_size, (size_t)WS_END); grid_blocks = -1; return; }
        int dev = 0, cus = 0, per_cu = 0;
        hipGetDevice(&dev);
        hipDeviceGetAttribute(&cus, hipDeviceAttributeMultiprocessorCount, dev);
        if (hipFuncSetAttribute((const void*)hybrid_fwd, hipFuncAttributeMaxDynamicSharedMemorySize, LDS_BYTES) != hipSuccess) { fprintf(stderr, "kernel_launch: hipFuncSetAttribute failed\n"); grid_blocks = -1; return; }
        hipOccupancyMaxActiveBlocksPerMultiprocessor(&per_cu, (const void*)hybrid_fwd, 512, LDS_BYTES);
        if (per_cu < 1) { fprintf(stderr, "kernel_launch: occupancy query says %d blocks per CU\n", per_cu); per_cu = 1; }
        (void)hipGetLastError();
        if (cus < 256) { fprintf(stderr, "kernel_launch: this kernel is built for a 256-CU device (found %d CUs)\n", cus); grid_blocks = -1; return; }
        grid_blocks = 256;
    }
    if (grid_blocks < 0) return;
    KArgs p{};
    for (int i = 0; i < 33; ++i) p.in[i] = (const float*)d_in[i];
    p.out = (float*)d_out; p.ws = (unsigned char*)d_ws;
    if (hipMemsetAsync((char*)d_ws + OFF_BAR, 0, 16384, stream) != hipSuccess) { fprintf(stderr, "kernel_launch: memset failed\n"); return; }
    void* args[] = {&p};
    hipError_t e = hipLaunchCooperativeKernel((const void*)hybrid_fwd, dim3(grid_blocks), dim3(512), args, LDS_BYTES, stream);
    if (e != hipSuccess) fprintf(stderr, "cooperative launch failed: %s (grid %d)\n", hipGetErrorString(e), grid_blocks);
}
```
